# Optimizing an MI355X kernel written in HIP

```python
import math
import jax, jax.numpy as jnp
from jax import lax
import numpy as np

D_MODEL = 2048
BATCH = 2
SEQ = 8192
DEPTH = 1

D_SG = D_MODEL // 2
SG_GROUPS = 8
SG_GROUP_DIM = D_SG // SG_GROUPS
SG_CHUNK = 128
ATT_HEADS = 8
HEAD_DIM = 128
D_ATT = ATT_HEADS * HEAD_DIM
MOBA_BLOCK = 256
MOBA_TOPK = 3
Q_CHUNK = 32
REL_BUCKETS = 32
REL_MAX_DIST = 128
N_GROUPS = 4
EXPERTS_PER_GROUP = 4
N_EXPERTS = N_GROUPS * EXPERTS_PER_GROUP
TOP_K_IN_GROUP = 2
D_EXPERT = 512
EPS = 1e-6
IN_SIZES = (D_SG, D_SG, D_ATT, D_ATT, D_ATT, D_MODEL, D_MODEL)
IN_COLS = sum(IN_SIZES)
IN_SPLITS = tuple(int(s) for s in np.cumsum(IN_SIZES)[:-1])

kernel_name = "gated_sgu_moba_hmoe_adaln_block"


def rmsnorm(x, w):
    xf = x.astype(jnp.float32)
    y = xf * lax.rsqrt(jnp.mean(xf * xf, axis=-1, keepdims=True) + EPS)
    return (y * w.astype(jnp.float32)).astype(x.dtype)


def layernorm(x, w, b):
    xf = x.astype(jnp.float32)
    mu = jnp.mean(xf, axis=-1, keepdims=True)
    var = jnp.mean(jnp.square(xf - mu), axis=-1, keepdims=True)
    y = (xf - mu) * lax.rsqrt(var + EPS)
    return (y * w.astype(jnp.float32) + b.astype(jnp.float32)).astype(x.dtype)


def t5_bucket(n):
    max_exact = REL_BUCKETS // 2
    nf = jnp.maximum(n, max_exact).astype(jnp.float32)
    large = max_exact + (jnp.log(nf / max_exact) / math.log(REL_MAX_DIST / max_exact)
                         * (REL_BUCKETS - max_exact)).astype(jnp.int32)
    large = jnp.minimum(large, REL_BUCKETS - 1)
    return jnp.where(n < max_exact, n, large)


def spatial_gating(u, v, ln_w, ln_b, w_s, b_s):
    B, S, _ = u.shape
    vn = layernorm(v, ln_w, ln_b).reshape(B, S // SG_CHUNK, SG_CHUNK, SG_GROUPS, SG_GROUP_DIM)
    causal = jnp.tril(jnp.ones((SG_CHUNK, SG_CHUNK), dtype=bool))
    w_m = jnp.where(causal[None], w_s, jnp.zeros_like(w_s))
    z = jnp.einsum('gts,bcsgd->bctgd', w_m, vn) + b_s.T[None, None, :, :, None]
    return u * z.reshape(B, S, D_SG)


def moba_attention(q, k, v, rel_bias):
    B, S, H, dh = q.shape
    nb = -(-S // MOBA_BLOCK)
    pad = nb * MOBA_BLOCK - S
    q = q.transpose(0, 2, 1, 3)
    kb = jnp.pad(k, ((0, 0), (0, pad), (0, 0), (0, 0))).transpose(0, 2, 1, 3).reshape(B, H, nb, MOBA_BLOCK, dh)
    vb = jnp.pad(v, ((0, 0), (0, pad), (0, 0), (0, 0))).transpose(0, 2, 1, 3).reshape(B, H, nb, MOBA_BLOCK, dh)
    qpos = jnp.arange(S, dtype=jnp.int32)
    own = qpos // MOBA_BLOCK
    kmean = jnp.mean(kb.astype(jnp.float32), axis=3)
    score = jnp.einsum('bhsd,bhnd->bhsn', q.astype(jnp.float32), kmean)
    past = jnp.arange(nb, dtype=jnp.int32)[None, :] < own[:, None]
    score = jnp.where(past[None, None], score, -jnp.inf)
    k_sel = min(MOBA_TOPK, nb)
    _, sel = lax.top_k(score, k_sel)
    sel = sel.astype(jnp.int32)
    sel_ok = sel < own[None, None, :, None]
    own_b = jnp.broadcast_to(own[None, None, :, None], (B, H, S, 1))
    blocks = jnp.concatenate([sel, own_b], axis=-1)
    ok = jnp.concatenate([sel_ok, jnp.ones_like(own_b, dtype=bool)], axis=-1)
    nqc = S // Q_CHUNK
    q_c = jnp.moveaxis(q.reshape(B, H, nqc, Q_CHUNK, dh), 2, 0)
    blk_c = jnp.moveaxis(blocks.reshape(B, H, nqc, Q_CHUNK, k_sel + 1), 2, 0)
    ok_c = jnp.moveaxis(ok.reshape(B, H, nqc, Q_CHUNK, k_sel + 1), 2, 0)
    qpos_c = qpos.reshape(nqc, Q_CHUNK)
    bi = jnp.arange(B)[:, None, None, None]
    hi = jnp.arange(H)[None, :, None, None]
    bias_t = rel_bias.T
    scale = HEAD_DIM ** -0.5
    key_off = jnp.arange(MOBA_BLOCK, dtype=jnp.int32)

    def one_chunk(args):
        qc, blk, okc, qp = args
        kg = kb[bi, hi, blk]
        vg = vb[bi, hi, blk]
        kpos = blk[..., None] * MOBA_BLOCK + key_off
        rel = qp[None, None, :, None, None] - kpos
        mask = okc[..., None] & (rel >= 0)
        bias = bias_t[hi[..., None], t5_bucket(jnp.maximum(rel, 0))]
        logits = jnp.einsum('bhqd,bhqnkd->bhqnk', qc, kg).astype(jnp.float32) * scale + bias.astype(jnp.float32)
        logits = jnp.where(mask, logits, -jnp.inf)
        p = jax.nn.softmax(logits, axis=(-2, -1))
        return jnp.einsum('bhqnk,bhqnkd->bhqd', p.astype(vg.dtype), vg)

    out = lax.map(one_chunk, (q_c, blk_c, ok_c, qpos_c))
    return out.transpose(1, 0, 3, 2, 4).reshape(B, S, H * dh)


def hierarchical_moe(h, w_rg, w_re, w1, w3, w2):
    B, S, D = h.shape
    t = h.reshape(B * S, D)
    g_prob = jax.nn.softmax((t @ w_rg).astype(jnp.float32), axis=-1)
    g_p, g_idx = lax.top_k(g_prob, 1)
    e_logits = (t @ w_re).astype(jnp.float32).reshape(-1, N_GROUPS, EXPERTS_PER_GROUP)
    e_logits = jnp.take_along_axis(e_logits, g_idx[:, :, None], axis=1)[:, 0]
    e_p, e_idx = lax.top_k(jax.nn.softmax(e_logits, axis=-1), TOP_K_IN_GROUP)
    e_p = e_p / jnp.sum(e_p, axis=-1, keepdims=True)
    weights = g_p * e_p
    expert_id = g_idx * EXPERTS_PER_GROUP + e_idx
    gates = jnp.sum(jax.nn.one_hot(expert_id, N_EXPERTS, dtype=jnp.float32) * weights[..., None], axis=1)

    def expert_step(acc, xs):
        w1e, w3e, w2e, ge = xs
        y = (jax.nn.silu(t @ w1e) * (t @ w3e)) @ w2e
        return acc + ge[:, None].astype(t.dtype) * y, None

    y, _ = lax.scan(expert_step, jnp.zeros_like(t), (w1, w3, w2, gates.T))
    return y.reshape(B, S, D)


def setup_inputs(seed: int = 0) -> dict:
    key = jax.random.key(seed)
    ks = jax.random.split(key, 24)
    f32 = jnp.float32
    nrm = lambda k, shape, s: jax.random.normal(k, shape, f32) * s
    L, D = DEPTH, D_MODEL
    return {
        "x": nrm(ks[0], (BATCH, SEQ, D), 1.0),
        "c": nrm(ks[1], (BATCH, D), 1.0),
        "w_ada": nrm(ks[2], (L, D, 6 * D), 0.5 * D ** -0.5),
        "b_ada": nrm(ks[3], (L, 6 * D), 0.02),
        "norm1_w": 1.0 + nrm(ks[4], (L, D), 0.05),
        "norm2_w": 1.0 + nrm(ks[5], (L, D), 0.05),
        "final_norm_w": 1.0 + nrm(ks[6], (D,), 0.05),
        "w_in": nrm(ks[7], (L, D, IN_COLS), D ** -0.5),
        "sg_ln_w": 1.0 + nrm(ks[8], (L, D_SG), 0.05),
        "sg_ln_b": nrm(ks[9], (L, D_SG), 0.02),
        "w_spatial": nrm(ks[10], (L, SG_GROUPS, SG_CHUNK, SG_CHUNK), SG_CHUNK ** -0.5),
        "b_spatial": 1.0 + nrm(ks[11], (L, SG_GROUPS, SG_CHUNK), 0.05),
        "rel_bias": nrm(ks[12], (REL_BUCKETS, ATT_HEADS), 0.5),
        "w_out_sg": nrm(ks[13], (L, D_SG, D), D_SG ** -0.5),
        "w_out_att": nrm(ks[14], (L, D_ATT, D), D_ATT ** -0.5),
        "w_o": nrm(ks[15], (L, D, D), D ** -0.5),
        "w_router_group": nrm(ks[16], (L, D, N_GROUPS), D ** -0.5),
        "w_router_expert": nrm(ks[17], (L, D, N_EXPERTS), D ** -0.5),
        "w_exp_gate": nrm(ks[18], (L, N_EXPERTS, D, D_EXPERT), D ** -0.5),
        "w_exp_up": nrm(ks[19], (L, N_EXPERTS, D, D_EXPERT), D ** -0.5),
        "w_exp_down": nrm(ks[20], (L, N_EXPERTS, D_EXPERT, D), D_EXPERT ** -0.5),
    }


def reference(x, c, w_ada, b_ada, norm1_w, norm2_w, final_norm_w, w_in, sg_ln_w, sg_ln_b,
              w_spatial, b_spatial, rel_bias, w_out_sg, w_out_att, w_o, w_router_group,
              w_router_expert, w_exp_gate, w_exp_up, w_exp_down):
    B, S, D = x.shape
    c_act = jax.nn.silu(c)
    for l in range(DEPTH):
        mod = c_act @ w_ada[l] + b_ada[l]
        sh1, sc1, g1, sh2, sc2, g2 = [m[:, None, :] for m in jnp.split(mod, 6, axis=-1)]
        h = rmsnorm(x, norm1_w[l]) * (1.0 + sc1) + sh1
        proj = h @ w_in[l]
        u_a, v_a, q, k, v, gate_sg, gate_att = jnp.split(proj, IN_SPLITS, axis=-1)
        y_sg = spatial_gating(jax.nn.gelu(u_a, approximate=False), jax.nn.gelu(v_a, approximate=False),
                              sg_ln_w[l], sg_ln_b[l], w_spatial[l], b_spatial[l])
        y_att = moba_attention(q.reshape(B, S, ATT_HEADS, HEAD_DIM), k.reshape(B, S, ATT_HEADS, HEAD_DIM),
                               v.reshape(B, S, ATT_HEADS, HEAD_DIM), rel_bias)
        merged = jax.nn.sigmoid(gate_sg) * (y_sg @ w_out_sg[l]) + jax.nn.sigmoid(gate_att) * (y_att @ w_out_att[l])
        x = x + g1 * (merged @ w_o[l])
        h2 = rmsnorm(x, norm2_w[l]) * (1.0 + sc2) + sh2
        x = x + g2 * hierarchical_moe(h2, w_router_group[l], w_router_expert[l],
                                      w_exp_gate[l], w_exp_up[l], w_exp_down[l])
    return rmsnorm(x, final_norm_w)
```

```cpp
#include <hip/hip_runtime.h>
#include <cstdio>
#include <cstdint>

#ifndef MK_N_LAUNCHES
#define MK_N_LAUNCHES 1
#endif

#define GAS __attribute__((address_space(1)))
#define LAS __attribute__((address_space(3)))
typedef unsigned short bf16;
typedef short bf16x8 __attribute__((ext_vector_type(8)));
typedef short s16x4 __attribute__((ext_vector_type(4)));
typedef float f32x2 __attribute__((ext_vector_type(2)));
typedef float f32x4 __attribute__((ext_vector_type(4)));
typedef float f32x16 __attribute__((ext_vector_type(16)));
typedef unsigned u32x2 __attribute__((ext_vector_type(2)));
typedef unsigned u32x4 __attribute__((ext_vector_type(4)));

constexpr int BATCH = 2, SEQ = 8192, DM = 2048, MTOK = BATCH * SEQ;
constexpr int DSG = 1024, DATT = 1024, NH = 8, HD = 128, NBLK = 32, INCOLS = 9216;
constexpr int NE = 16, DE = 512;
constexpr float EPS = 1e-6f;
constexpr float LOG2E = 1.4426950408889634f;
constexpr int NWAVES = 8, NTHR = 512;

constexpr size_t MiB = 1u << 20;
constexpr size_t WS_CTL = 0, CTL_ZERO_BYTES = 1 * MiB;
constexpr size_t WS_MOD = 1 * MiB;
constexpr size_t WS_RCONST = 1 * MiB + 128 * 1024;
constexpr size_t WS_A2 = 1 * MiB + 192 * 1024;
constexpr size_t WS_WR = 1 * MiB + 256 * 1024;
constexpr size_t WS_SSQ = 2 * MiB;
constexpr size_t WS_SLOTTOK = 4 * MiB;
constexpr size_t WS_SLOTW = 5 * MiB;
constexpr size_t WS_ML = 6 * MiB;
constexpr size_t WS_LISTS = 10 * MiB;
constexpr size_t WS_WINT = 20 * MiB;
constexpr size_t WS_WOSGT = 56 * MiB;
constexpr size_t WS_WOATTT = 60 * MiB;
constexpr size_t WS_WOT = 64 * MiB;
constexpr size_t WS_H = 72 * MiB;
constexpr size_t WS_U = 136 * MiB;
constexpr size_t WS_VG = 168 * MiB;
constexpr size_t WS_Q = 200 * MiB;
constexpr size_t WS_K = 232 * MiB;
constexpr size_t WS_V = 264 * MiB;
constexpr size_t WS_GS = 296 * MiB;
constexpr size_t WS_GA = 360 * MiB;
constexpr size_t WS_YSG = 424 * MiB;
constexpr size_t WS_YATT = 456 * MiB;
constexpr size_t WS_END = 488 * MiB;
constexpr size_t WS_OPART = 72 * MiB;
constexpr size_t WS_MERGED = 200 * MiB;
constexpr size_t WS_TMP = 72 * MiB;
constexpr size_t WS_H2 = 72 * MiB;
constexpr size_t WS_W13T = 136 * MiB;
constexpr size_t WS_W2T = 264 * MiB;
constexpr size_t WS_ACT = 296 * MiB;
constexpr size_t WS_O0 = 332 * MiB;
constexpr size_t WS_O1 = 396 * MiB;
constexpr int LIST_PER_BH = 135168;
constexpr int CW_TMO = 0;
constexpr int CW_BAR = 4096;
constexpr int CW_ACNT = 8192;
constexpr int CW_ECNT = 9216;
constexpr int CW_KSUM = 16384;

constexpr int LDS_BYTES = 147456;
constexpr int RING_BYTES = 131072;
constexpr int TAB_OFF = 143360;
constexpr int MISC_OFF = 146432;

#define LDS_WAIT() asm volatile("s_waitcnt lgkmcnt(0)" ::: "memory")
#define VM_WAIT() asm volatile("s_waitcnt vmcnt(0)" ::: "memory")
__device__ __forceinline__ unsigned cvt_pk_bf16(float lo, float hi) { unsigned r; asm volatile("v_cvt_pk_bf16_f32 %0, %1, %2" : "=v"(r) : "v"(lo), "v"(hi)); return r; }
__device__ __forceinline__ float bf_lo(unsigned w) { return __uint_as_float(w << 16); }
__device__ __forceinline__ float bf_hi(unsigned w) { return __uint_as_float(w & 0xffff0000u); }
__device__ __forceinline__ float wave_sum(float v) {
#pragma unroll
    for (int o = 1; o < 64; o <<= 1) v += __shfl_xor(v, o);
    return v;
}
__device__ __forceinline__ f32x2 gelu_pk(f32x2 v) {
    const f32x2 av = __builtin_elementwise_abs(v), d = av * 0.2316418882f + 1.0f;
    f32x2 t; t.x = __builtin_amdgcn_rcpf(d.x); t.y = __builtin_amdgcn_rcpf(d.y);
    f32x2 q = t * 0.5307027145f + (-0.7265760135f); q = q * t + 0.7107068705f; q = q * t + (-0.142248368f); q = q * t + 0.127414796f; q = q * t;
    const f32x2 s = (v * v) * (-0.72134752044f);
    f32x2 e; e.x = __builtin_amdgcn_exp2f(s.x); e.y = __builtin_amdgcn_exp2f(s.y);
    const f32x2 m = v * (q * e), r = v - m;
    f32x2 o; o.x = v.x < 0.f ? m.x : r.x; o.y = v.y < 0.f ? m.y : r.y; return o;
}
__device__ __forceinline__ int lane_id() { return (int)__builtin_amdgcn_mbcnt_hi(~0u, __builtin_amdgcn_mbcnt_lo(~0u, 0u)); }
__device__ __forceinline__ float sigmoid_f(float x) { return __builtin_amdgcn_rcpf(1.0f + __builtin_amdgcn_exp2f(-x * LOG2E)); }

#define XB_TMO      128
#define XB_XCNT(j)  (256  + 64 * (j))
#define XB_XSUB(j)  (1280 + 64 * (j))
#define XB_XGEN(j)  (2304 + 64 * (j))
#define XB_TOP      3328
#define XB_TOPGEN   3392
#define XCD_BAR_WORDS 3456
#define XB_SPIN_CAP (1u << 18)
__device__ __forceinline__ unsigned xb_ld(unsigned* p)              { return __hip_atomic_load(p, __ATOMIC_RELAXED, __HIP_MEMORY_SCOPE_AGENT); }
__device__ __forceinline__ unsigned xb_add(unsigned* p, unsigned v) { return __hip_atomic_fetch_add(p, v, __ATOMIC_RELAXED, __HIP_MEMORY_SCOPE_AGENT); }
__device__ __forceinline__ unsigned xb_xcc_id() { return (unsigned)__builtin_amdgcn_s_getreg((3 << 11) | 20) & 0xFu; }
#define XB_SPIN(cond, bar) do { unsigned _sp = 0; while (cond) { __builtin_amdgcn_s_sleep(1); \
    if ((++_sp & 255u) == 0u) { if (xb_ld(&(bar)[XB_TMO])) break; if (_sp > XB_SPIN_CAP) { atomicAdd(&(bar)[XB_TMO], 1u); break; } } } } while (0)
struct XcdBarrier { unsigned* bar; unsigned x; volatile LAS unsigned* st; int wid; };
__device__ __forceinline__ XcdBarrier xcd_barrier_post(unsigned* bar, volatile LAS unsigned* st, int wid) {
    XcdBarrier b; b.bar = bar; b.x = xb_xcc_id(); b.st = st; b.wid = wid;
    if (wid == 0 && lane_id() == 0) (void)xb_add(&bar[XB_XCNT(b.x)], 1u);
    return b;
}
__device__ __forceinline__ void xcd_barrier_complete(unsigned* bar, unsigned x, unsigned& nloc, unsigned& nx) {
    const unsigned G = gridDim.x * gridDim.y * gridDim.z;
    unsigned sum, cnt, mine, sp = 0u;
    for (;;) {
        sum = 0u; cnt = 0u; mine = 0u;
#pragma unroll
        for (unsigned j = 0; j < 16; ++j) { const unsigned c = xb_ld(&bar[XB_XCNT(j)]); sum += c; cnt += (c > 0u) ? 1u : 0u; mine = (j == x) ? c : mine; }
        if (sum == G) break;
        __builtin_amdgcn_s_sleep(1);
        if ((++sp & 255u) == 0u) { if (xb_ld(&bar[XB_TMO])) break; if (sp > XB_SPIN_CAP) { atomicAdd(&bar[XB_TMO], 1u); break; } }
    }
    nloc = mine > 0u ? mine : 1u; nx = cnt > 0u ? cnt : 1u;
}
__device__ __forceinline__ void xcd_barrier(const XcdBarrier& b) {
    asm volatile("s_waitcnt vmcnt(0)" ::: "memory");
    __syncthreads();
    if (b.wid == 0 && lane_id() == 0) {
        unsigned* bar = b.bar;
        __builtin_amdgcn_s_waitcnt(0);
        unsigned nloc = b.st[0], nx = b.st[1];
        if (nloc == 0u) { xcd_barrier_complete(bar, b.x, nloc, nx); b.st[0] = nloc; b.st[1] = nx; }
        const unsigned old = xb_add(&bar[XB_XSUB(b.x)], 1u);
        const unsigned gen = old / nloc;
        if (old + 1u == (gen + 1u) * nloc) {
            __builtin_amdgcn_fence(__ATOMIC_RELEASE, "agent");
            asm volatile("s_waitcnt vmcnt(0)" ::: "memory");
            const unsigned og = xb_add(&bar[XB_TOP], 1u);
            const unsigned tg = og / nx;
            if (og + 1u == (tg + 1u) * nx) xb_add(&bar[XB_TOPGEN], 1u);
            else XB_SPIN(xb_ld(&bar[XB_TOPGEN]) == tg, bar);
            __builtin_amdgcn_fence(__ATOMIC_ACQUIRE, "agent");
            xb_add(&bar[XB_XGEN(b.x)], 1u);
            asm volatile("s_waitcnt vmcnt(0)" ::: "memory");
        } else {
            XB_SPIN(xb_ld(&bar[XB_XGEN(b.x)]) == gen, bar);
            __builtin_amdgcn_fence(__ATOMIC_ACQUIRE, "agent");
            asm volatile("s_waitcnt vmcnt(0)" ::: "memory");
        }
    }
    __syncthreads();
}

namespace pg8 {
constexpr int BM = 256, BK = 64, HALF = 128, HTB = HALF * BK * 2, STAGE_BYTES = 8 * HTB;
__host__ __device__ __forceinline__ int lds_byte(int r, int c) { const int st = (r >> 4) * 2 + (c >> 5), rr = r & 15, cc = c & 31, ob = rr * 64 + cc * 2; return st * 1024 + (ob ^ (((ob >> 9) & 1) << 5)); }
__host__ __device__ __forceinline__ void stage_rc(int b, int& R, int& C) { const int st = b / 1024, sb = b % 1024, swz = sb ^ (((sb >> 9) & 1) << 5); R = (st >> 1) * 16 + swz / 64; C = (st & 1) * 32 + (swz % 64) / 2; }
__host__ __device__ __forceinline__ int perm32(int rho) { const int n = rho >> 4, i = rho & 15; return 8 * (i >> 2) + 4 * n + (i & 3); }

struct Unit { const char* A; const char* B; int pm, pn, kind, aux; };

template <int K, bool PERM, bool GATHER, class Sched, class Epi>
__device__ __forceinline__ void gemm_phase(LAS unsigned char* lds, const int wid, const Sched& S, const Epi& E) {
    const int lane = lane_id(), tid = wid * 64 + lane, wr = wid >> 2, wc = wid & 3, fr = lane & 15, fq = lane >> 4;
    constexpr int nt = K / BK;
    int Rr[2], Cc[2]; unsigned voffB[2];
#pragma unroll
    for (int i = 0; i < 2; ++i) { int R, C; stage_rc(tid * 16 + i * 8192, R, C); Rr[i] = R; Cc[i] = C; const int Rb = PERM ? ((R & ~31) + perm32(R & 31)) : R; voffB[i] = (unsigned)(Rb * K + C) * 2u; }
    constexpr size_t kstep = (size_t)(BK * 2);
    constexpr size_t hstep = (size_t)HALF * K * 2;
    const unsigned ldsw = (unsigned)wid * 1024u;
    const int aoff = lds_byte(wr * 64 + fr, fq * 8), boff = lds_byte(wc * 32 + fr, fq * 8);
#define PG8_SA(b, h) (((b) * 2 + (h)) * HTB)
#define PG8_SB(b, h) ((4 + (b) * 2 + (h)) * HTB)
#define PG8_STAGE_B(b, h, gbase) do { _Pragma("unroll") for (int _i = 0; _i < 2; ++_i) \
        __builtin_amdgcn_global_load_lds((const unsigned*)((const char*)(gbase) + (size_t)(h) * hstep + voffB[_i]), (LAS unsigned*)(lds + PG8_SB(b, h) + ldsw + _i * 8192), 16, 0, 0); } while (0)
#define PG8_STAGE_A(b, h, gbase, VO) do { _Pragma("unroll") for (int _i = 0; _i < 2; ++_i) \
        __builtin_amdgcn_global_load_lds((const unsigned*)((const char*)(gbase) + (VO)[h][_i]), (LAS unsigned*)(lds + PG8_SA(b, h) + ldsw + _i * 8192), 16, 0, 0); } while (0)
#define PG8_LDA(dst, b, h) do { _Pragma("unroll") for (int m = 0; m < 4; ++m) _Pragma("unroll") for (int k = 0; k < 2; ++k) dst[m][k] = *(const LAS bf16x8*)(lds + PG8_SA(b, h) + aoff + m * 2048 + k * 1024); } while (0)
#define PG8_LDB(dst, b, h) do { _Pragma("unroll") for (int n = 0; n < 2; ++n) _Pragma("unroll") for (int k = 0; k < 2; ++k) dst[n][k] = *(const LAS bf16x8*)(lds + PG8_SB(b, h) + boff + n * 2048 + k * 1024); } while (0)
#define PG8_MMA(ai, bj, At, Bt) do { __builtin_amdgcn_s_setprio(1); _Pragma("unroll") for (int m = 0; m < 4; ++m) _Pragma("unroll") for (int n = 0; n < 2; ++n) _Pragma("unroll") for (int k = 0; k < 2; ++k) \
        acc[ai][bj][m][n] = __builtin_amdgcn_mfma_f32_16x16x32_bf16(Bt[n][k], At[m][k], acc[ai][bj][m][n], 0, 0, 0); __builtin_amdgcn_s_setprio(0); } while (0)
#define PG8_WAIT_V(n) asm volatile("s_waitcnt vmcnt(" #n ")" ::: "memory")
#define PG8_WAIT_L(n) asm volatile("s_waitcnt lgkmcnt(" #n ")" ::: "memory")
#define PG8_BAR __builtin_amdgcn_s_barrier()
#define PG8_SCHED __builtin_amdgcn_sched_barrier(0)
#define PG8_SETVO(VO, U) do { _Pragma("unroll") for (int _h = 0; _h < 2; ++_h) _Pragma("unroll") for (int _i = 0; _i < 2; ++_i) { \
        if constexpr (GATHER) (VO)[_h][_i] = ((unsigned)S.row_of((U), _h * HALF + Rr[_i]) * (unsigned)K + (unsigned)Cc[_i]) * 2u; \
        else (VO)[_h][_i] = (unsigned)(((_h * HALF + Rr[_i]) * K + Cc[_i]) * 2); } } while (0)
    Unit cur, nxt; int ui = 0;
    if (!S.next(0, cur)) return;
    f32x4 acc[2][2][4][2];
#pragma unroll
    for (int a = 0; a < 2; ++a)
#pragma unroll
        for (int b = 0; b < 2; ++b)
#pragma unroll
            for (int m = 0; m < 4; ++m)
#pragma unroll
                for (int n = 0; n < 2; ++n) acc[a][b][m][n] = (f32x4){0.f, 0.f, 0.f, 0.f};
    bf16x8 At[4][2], B0[2][2], B1[2][2];
    unsigned voC[2][2], voN[2][2];
    PG8_SETVO(voC, cur);
    const char* cA = cur.A; const char* cB = cur.B;
    PG8_STAGE_B(0, 0, cB); PG8_STAGE_B(0, 1, cB); PG8_STAGE_A(0, 0, cA, voC); PG8_STAGE_A(0, 1, cA, voC);
    if (wr == 1) PG8_BAR;
    PG8_WAIT_V(2); PG8_BAR;
    PG8_STAGE_B(1, 0, cB + kstep); PG8_STAGE_A(1, 0, cA + kstep, voC); PG8_STAGE_B(1, 1, cB + kstep);
    PG8_WAIT_V(6); PG8_BAR;
    for (;;) {
        const bool has_next = S.next(ui + 1, nxt);
        const char* nA = has_next ? nxt.A : cA; const char* nB = has_next ? nxt.B : cB;
        if constexpr (GATHER) { if (has_next) { PG8_SETVO(voN, nxt); } else {
#pragma unroll
            for (int _h = 0; _h < 2; ++_h)
#pragma unroll
                for (int _i = 0; _i < 2; ++_i) voN[_h][_i] = voC[_h][_i]; } }
        for (int t = 0; t < nt; t += 2) {
            const bool last = (t == nt - 2);
            const char* a1 = cA + (size_t)(t + 1) * kstep;
            const char* a2 = last ? nA : cA + (size_t)(t + 2) * kstep; const char* b2 = last ? nB : cB + (size_t)(t + 2) * kstep;
            const char* a3 = a2 + kstep; const char* b3 = b2 + kstep;
            unsigned vo2[2][2];
#pragma unroll
            for (int _h = 0; _h < 2; ++_h)
#pragma unroll
                for (int _i = 0; _i < 2; ++_i) { if constexpr (GATHER) vo2[_h][_i] = last ? voN[_h][_i] : voC[_h][_i]; else vo2[_h][_i] = voC[_h][_i]; }
            PG8_LDB(B0, 0, 0); PG8_LDB(B1, 0, 1); PG8_SCHED; PG8_LDA(At, 0, 0); PG8_STAGE_A(1, 1, a1, voC);
            PG8_WAIT_V(8); PG8_WAIT_L(0); PG8_BAR; PG8_MMA(0, 0, At, B0); PG8_MMA(0, 1, At, B1); PG8_BAR; PG8_SCHED;
            PG8_LDA(At, 0, 1); PG8_STAGE_B(0, 0, b2); PG8_STAGE_B(0, 1, b2); PG8_STAGE_A(0, 0, a2, vo2);
            PG8_WAIT_V(8); PG8_WAIT_L(0); PG8_BAR; PG8_MMA(1, 0, At, B0); PG8_MMA(1, 1, At, B1); PG8_BAR; PG8_SCHED;
            PG8_LDB(B0, 1, 0); PG8_LDB(B1, 1, 1); PG8_SCHED; PG8_LDA(At, 1, 0); PG8_STAGE_A(0, 1, a2, vo2);
            PG8_WAIT_V(8); PG8_WAIT_L(0); PG8_BAR; PG8_MMA(0, 0, At, B0); PG8_MMA(0, 1, At, B1); PG8_BAR; PG8_SCHED;
            PG8_LDA(At, 1, 1); PG8_STAGE_B(1, 0, b3); PG8_STAGE_B(1, 1, b3); PG8_STAGE_A(1, 0, a3, vo2);
            PG8_WAIT_V(8); PG8_WAIT_L(0); PG8_BAR; PG8_MMA(1, 0, At, B0); PG8_MMA(1, 1, At, B1); PG8_BAR; PG8_SCHED;
        }
        if (wr == 0) PG8_BAR;
        E(acc, cur, wr, wc, fr, fq);
        if (!has_next) break;
        if (!(Epi::CHAIN && cur.kind == 0)) {
#pragma unroll
        for (int a = 0; a < 2; ++a)
#pragma unroll
            for (int b = 0; b < 2; ++b)
#pragma unroll
                for (int m = 0; m < 4; ++m)
#pragma unroll
                    for (int n = 0; n < 2; ++n) acc[a][b][m][n] = (f32x4){0.f, 0.f, 0.f, 0.f};
        }
        cur = nxt; cA = nA; cB = nB; ++ui;
        if constexpr (GATHER) {
#pragma unroll
            for (int _h = 0; _h < 2; ++_h)
#pragma unroll
                for (int _i = 0; _i < 2; ++_i) voC[_h][_i] = voN[_h][_i]; }
        if (wr == 1) PG8_BAR;
    }
    PG8_WAIT_V(0);
    PG8_BAR;
#undef PG8_SA
#undef PG8_SB
#undef PG8_STAGE_A
#undef PG8_STAGE_B
#undef PG8_LDA
#undef PG8_LDB
#undef PG8_MMA
#undef PG8_WAIT_V
#undef PG8_WAIT_L
#undef PG8_BAR
#undef PG8_SCHED
#undef PG8_SETVO
}
}

struct Frame {
    LAS unsigned char* lds;
    volatile LAS unsigned* MISC;
    unsigned* ctl;
    unsigned char* ws;
    int tid, lane, wave, vcu, G;
    const float *x, *c, *w_ada, *b_ada, *norm1_w, *norm2_w, *final_w, *w_in, *sg_ln_w, *sg_ln_b, *w_spatial, *b_spatial, *rel_bias, *w_out_sg, *w_out_att, *w_o, *w_rg, *w_re, *w_eg, *w_eu, *w_ed;
    float* out;
};

__device__ __forceinline__ void transpose_item(const float* W, int ldw, bf16* WT, int ldt, int k0, int n0, int out_row0, LAS float* scr, int lane) {
#pragma unroll 8
    for (int i = 0; i < 32; ++i) { const int kk = 2 * i + (lane >> 5); scr[kk * 33 + (lane & 31)] = W[(size_t)(k0 + kk) * ldw + n0 + (lane & 31)]; }
    LDS_WAIT(); asm volatile("" ::: "memory");
    const int c = lane & 7;
#pragma unroll
    for (int j = 0; j < 4; ++j) { const int n = (lane >> 3) + 8 * j; const LAS float* s = scr + (8 * c) * 33 + n;
        u32x4 o; o.x = cvt_pk_bf16(s[0 * 33], s[1 * 33]); o.y = cvt_pk_bf16(s[2 * 33], s[3 * 33]); o.z = cvt_pk_bf16(s[4 * 33], s[5 * 33]); o.w = cvt_pk_bf16(s[6 * 33], s[7 * 33]);
        *(u32x4*)(WT + (size_t)(out_row0 + n) * ldt + k0 + 8 * c) = o; }
    LDS_WAIT(); asm volatile("" ::: "memory");
}

__device__ __forceinline__ void p0_prologue(Frame& F) {
    LAS float* scr = (LAS float*)(F.lds + F.wave * 16384);
    const int gw = F.vcu * NWAVES + F.wave, NGW = F.G * NWAVES;
    bf16* WINT = (bf16*)(F.ws + WS_WINT); bf16* WOSGT = (bf16*)(F.ws + WS_WOSGT); bf16* WOATTT = (bf16*)(F.ws + WS_WOATTT); bf16* WOT = (bf16*)(F.ws + WS_WOT);
    constexpr int I_IN = (DM / 64) * (INCOLS / 32), I_SG = (DSG / 64) * (DM / 32), I_O = (DM / 64) * (DM / 32);
    constexpr int NITEMS = I_IN + 2 * I_SG + I_O;
    for (int it = gw; it < NITEMS; it += NGW) {
        int r = it;
        if (r < I_IN) { const int nb = INCOLS / 32; transpose_item(F.w_in, INCOLS, WINT, DM, 64 * (r / nb), 32 * (r % nb), 32 * (r % nb), scr, F.lane); continue; } r -= I_IN;
        if (r < I_SG) { const int nb = DM / 32; transpose_item(F.w_out_sg, DM, WOSGT, DSG, 64 * (r / nb), 32 * (r % nb), 32 * (r % nb), scr, F.lane); continue; } r -= I_SG;
        if (r < I_SG) { const int nb = DM / 32; transpose_item(F.w_out_att, DM, WOATTT, DATT, 64 * (r / nb), 32 * (r % nb), 32 * (r % nb), scr, F.lane); continue; } r -= I_SG;
        { const int nb = DM / 32; transpose_item(F.w_o, DM, WOT, DM, 64 * (r / nb), 32 * (r % nb), 32 * (r % nb), scr, F.lane); }
    }
    __syncthreads();
    {
        float* mod = (float*)(F.ws + WS_MOD);
        LAS float* red = (LAS float*)F.lds;
        for (int cb = F.vcu; cb < (6 * DM) / 48; cb += F.G) {
            const int kq = F.tid / 12, cq = F.tid % 12;
            f32x4 a0 = {0.f, 0.f, 0.f, 0.f}, a1 = {0.f, 0.f, 0.f, 0.f};
            if (F.tid < 504) {
                for (int k = kq; k < DM; k += 42) {
                    const f32x4 w = *(const f32x4*)(F.w_ada + (size_t)k * (6 * DM) + cb * 48 + cq * 4);
                    const float c0 = F.c[k], c1 = F.c[DM + k];
                    const float s0 = c0 * sigmoid_f(c0), s1 = c1 * sigmoid_f(c1);
                    a0 += w * s0; a1 += w * s1;
                }
                *(LAS f32x4*)(red + (kq * 12 + cq) * 8) = a0; *(LAS f32x4*)(red + (kq * 12 + cq) * 8 + 4) = a1;
            }
            __syncthreads();
            if (F.tid < 96) {
                const int b = F.tid / 48, col = F.tid % 48, cq2 = col / 4, e = col % 4;
                float s = 0.f;
                for (int q = 0; q < 42; ++q) s += red[(q * 12 + cq2) * 8 + b * 4 + e];
                mod[b * (6 * DM) + cb * 48 + col] = s + F.b_ada[cb * 48 + col];
            }
            __syncthreads();
        }
    }
}

__device__ __forceinline__ void p1_norm1(Frame& F) {
    const int gw = F.vcu * NWAVES + F.wave, NGW = F.G * NWAVES;
    const float* mod = (const float*)(F.ws + WS_MOD);
    bf16* H = (bf16*)(F.ws + WS_H);
    int curb = -1; f32x4 av[8], sv[8];
    for (int m = gw; m < MTOK; m += NGW) {
        const int b = m / SEQ;
        if (b != curb) { curb = b;
#pragma unroll
            for (int j = 0; j < 8; ++j) { const int col = 4 * F.lane + 256 * j;
                const f32x4 w = *(const f32x4*)(F.norm1_w + col), sc = *(const f32x4*)(mod + b * (6 * DM) + DM + col);
                av[j] = w * (sc + 1.0f); sv[j] = *(const f32x4*)(mod + b * (6 * DM) + col); } }
        const f32x4* xr = (const f32x4*)(F.x + (size_t)m * DM) + F.lane;
        f32x4 v[8]; float s = 0.f;
#pragma unroll
        for (int j = 0; j < 8; ++j) { v[j] = xr[64 * j]; s += (v[j].x * v[j].x + v[j].y * v[j].y) + (v[j].z * v[j].z + v[j].w * v[j].w); }
        const float rstd = 1.0f / sqrtf(wave_sum(s) * (1.0f / DM) + EPS);
        u32x2* o8 = (u32x2*)(H + (size_t)m * DM) + F.lane;
#pragma unroll
        for (int j = 0; j < 8; ++j) { const f32x4 h = v[j] * rstd * av[j] + sv[j]; u32x2 w; w.x = cvt_pk_bf16(h.x, h.y); w.y = cvt_pk_bf16(h.z, h.w); o8[64 * j] = w; }
    }
    float* A2 = (float*)(F.ws + WS_A2); bf16* WR = (bf16*)(F.ws + WS_WR); float* RC = (float*)(F.ws + WS_RCONST);
    for (int idx = F.vcu * NTHR + F.tid; idx < BATCH * 32 * DM; idx += F.G * NTHR) {
        const int k = idx % DM, col = (idx / DM) % 32, b = idx / (32 * DM);
        const float a2 = F.norm2_w[k] * (1.0f + mod[b * (6 * DM) + 4 * DM + k]);
        if (col == 0) A2[b * DM + k] = a2;
        const float w = col < 4 ? F.w_rg[k * 4 + col] : (col < 20 ? F.w_re[k * 16 + (col - 4)] : 0.f);
        const float v = a2 * w;
        const unsigned hi = cvt_pk_bf16(v, 0.f) & 0xffffu; const float lo = v - bf_lo(hi);
        WR[((size_t)(b * 2 + 0) * 32 + col) * DM + k] = (bf16)hi;
        WR[((size_t)(b * 2 + 1) * 32 + col) * DM + k] = (bf16)(cvt_pk_bf16(lo, 0.f) & 0xffffu);
    }
    for (int it = gw; it < BATCH * 32; it += NGW) {
        const int b = it / 32, col = it % 32; float s = 0.f;
        for (int k = F.lane; k < DM; k += 64) { const float w = col < 4 ? F.w_rg[k * 4 + col] : (col < 20 ? F.w_re[k * 16 + (col - 4)] : 0.f); s += mod[b * (6 * DM) + 3 * DM + k] * w; }
        s = wave_sum(s);
        if (F.lane == 0) RC[b * 32 + col] = s;
    }
}

struct SchedGrid {
    const char* A; const char* B; int nN, nwg, G, c; size_t a_tstep, b_tstep;
    __device__ __forceinline__ bool next(int i, pg8::Unit& u) const {
        const int L = i * G + c; if (L >= nwg) return false;
        const int nig = 8 * nN, gid = L / nig, rem = L % nig;
        u.pm = gid * 8 + (rem & 7); u.pn = rem >> 3; u.kind = 0; u.aux = 0;
        u.A = A + (size_t)u.pm * a_tstep; u.B = B + (size_t)u.pn * b_tstep; return true;
    }
    __device__ __forceinline__ int row_of(const pg8::Unit&, int) const { return 0; }
};

struct EpiProj {
    static constexpr bool CHAIN = false;
    unsigned char* ws; float* ksum;
    __device__ __forceinline__ void operator()(f32x4 (&acc)[2][2][4][2], const pg8::Unit& u, int wr, int wc, int fr, int fq) const {
        const int pn = u.pn; int act, ld, colt; bf16* base;
        if (pn < 20) { const int t = pn >> 2; base = (bf16*)(ws + WS_U + (size_t)t * (32 * MiB)); ld = 1024; colt = (pn & 3) * 256; act = (t < 2) ? 1 : 0; }
        else { const int t = (pn - 20) >> 3; base = (bf16*)(ws + WS_GS + (size_t)t * (64 * MiB)); ld = 2048; colt = ((pn - 20) & 7) * 256; act = 2; }
        const int row0 = u.pm * 256 + wr * 64 + fr, col0 = colt + wc * 32 + 8 * fq;
        if (pn >= 12 && pn < 16) {
            const int b = u.pm >> 5, blk = u.pm & 31;
#pragma unroll
            for (int bj = 0; bj < 2; ++bj)
#pragma unroll
                for (int n = 0; n < 2; ++n) {
                    f32x4 s = {0.f, 0.f, 0.f, 0.f};
#pragma unroll
                    for (int ai = 0; ai < 2; ++ai)
#pragma unroll
                        for (int m = 0; m < 4; ++m) s += acc[ai][bj][m][n];
#pragma unroll
                    for (int o = 1; o < 16; o <<= 1) { s.x += __shfl_xor(s.x, o); s.y += __shfl_xor(s.y, o); s.z += __shfl_xor(s.z, o); s.w += __shfl_xor(s.w, o); }
                    if (fr == 0) { float* dst = ksum + (((b * 8 + (pn - 12) * 2 + bj) * 32 + blk) * 128 + wc * 32 + 8 * fq + 4 * n);
                        atomicAdd(dst + 0, s.x); atomicAdd(dst + 1, s.y); atomicAdd(dst + 2, s.z); atomicAdd(dst + 3, s.w); }
                }
        }
#pragma unroll
        for (int ai = 0; ai < 2; ++ai)
#pragma unroll
            for (int m = 0; m < 4; ++m) { bf16* rowp = base + (size_t)(row0 + ai * 128 + m * 16) * ld + col0;
#pragma unroll
                for (int bj = 0; bj < 2; ++bj) { f32x4 v0 = acc[ai][bj][m][0], v1 = acc[ai][bj][m][1];
                    if (act == 1) { const f32x2 a = gelu_pk((f32x2){v0[0], v0[1]}), b = gelu_pk((f32x2){v0[2], v0[3]}), c = gelu_pk((f32x2){v1[0], v1[1]}), d = gelu_pk((f32x2){v1[2], v1[3]});
                        v0 = (f32x4){a.x, a.y, b.x, b.y}; v1 = (f32x4){c.x, c.y, d.x, d.y}; }
                    else if (act == 2) {
#pragma unroll
                        for (int j = 0; j < 4; ++j) { v0[j] = sigmoid_f(v0[j]); v1[j] = sigmoid_f(v1[j]); } }
                    u32x4 w; w.x = cvt_pk_bf16(v0[0], v0[1]); w.y = cvt_pk_bf16(v0[2], v0[3]); w.z = cvt_pk_bf16(v1[0], v1[1]); w.w = cvt_pk_bf16(v1[2], v1[3]);
                    *(u32x4*)(rowp + bj * 128) = w; } }
    }
};

struct SchedPair {
    const char *A0, *A1, *B0, *B1; int G, c;
    __device__ __forceinline__ bool next(int i, pg8::Unit& u) const {
        const int L = (i >> 1) * G + c; if (L >= 512) return false;
        const int part = i & 1, gid = L >> 6, rem = L & 63;
        u.pm = gid * 8 + (rem & 7); u.pn = rem >> 3; u.kind = part; u.aux = 0;
        u.A = (part ? A1 : A0) + (size_t)u.pm * (256 * 1024 * 2); u.B = (part ? B1 : B0) + (size_t)u.pn * (256 * 1024 * 2); return true;
    }
    __device__ __forceinline__ int row_of(const pg8::Unit&, int) const { return 0; }
};
struct EpiMerge {
    static constexpr bool CHAIN = true;
    const bf16 *GS, *GA; bf16* MERGED;
    __device__ __forceinline__ void operator()(f32x4 (&acc)[2][2][4][2], const pg8::Unit& u, int wr, int wc, int fr, int fq) const {
        const int row0 = u.pm * 256 + wr * 64 + fr, col0 = u.pn * 256 + wc * 32 + 8 * fq;
#pragma unroll
        for (int ai = 0; ai < 2; ++ai)
#pragma unroll
            for (int m = 0; m < 4; ++m) { const size_t off = (size_t)(row0 + ai * 128 + m * 16) * DM + col0;
#pragma unroll
                for (int bj = 0; bj < 2; ++bj) {
                    const u32x4 ga = *(const u32x4*)(GA + off + bj * 128);
                    const f32x4 a0 = {bf_lo(ga.x), bf_hi(ga.x), bf_lo(ga.y), bf_hi(ga.y)}, a1 = {bf_lo(ga.z), bf_hi(ga.z), bf_lo(ga.w), bf_hi(ga.w)};
                    if (u.kind == 0) {
                        const u32x4 gs = *(const u32x4*)(GS + off + bj * 128);
                        const f32x4 s0 = {bf_lo(gs.x), bf_hi(gs.x), bf_lo(gs.y), bf_hi(gs.y)}, s1 = {bf_lo(gs.z), bf_hi(gs.z), bf_lo(gs.w), bf_hi(gs.w)};
#pragma unroll
                        for (int j = 0; j < 4; ++j) { acc[ai][bj][m][0][j] *= s0[j] * __builtin_amdgcn_rcpf(a0[j]); acc[ai][bj][m][1][j] *= s1[j] * __builtin_amdgcn_rcpf(a1[j]); }
                    } else {
                        const f32x4 v0 = acc[ai][bj][m][0] * a0, v1 = acc[ai][bj][m][1] * a1;
                        u32x4 w; w.x = cvt_pk_bf16(v0[0], v0[1]); w.y = cvt_pk_bf16(v0[2], v0[3]); w.z = cvt_pk_bf16(v1[0], v1[1]); w.w = cvt_pk_bf16(v1[2], v1[3]);
                        *(u32x4*)(MERGED + off + bj * 128) = w; } }
                asm volatile("" ::: "memory"); }
    }
};

struct EpiX1 {
    static constexpr bool CHAIN = false;
    const float* x; const float* mod; float* out; float* ssq;
    __device__ __forceinline__ void operator()(f32x4 (&acc)[2][2][4][2], const pg8::Unit& u, int wr, int wc, int fr, int fq) const {
        const int row0 = u.pm * 256 + wr * 64 + fr, col0 = u.pn * 256 + wc * 32 + 4 * fq;
        const float* g1 = mod + (u.pm >> 5) * (6 * DM) + 2 * DM + col0;
        f32x4 gv[2][2];
#pragma unroll
        for (int bj = 0; bj < 2; ++bj)
#pragma unroll
            for (int n = 0; n < 2; ++n) gv[bj][n] = *(const f32x4*)(g1 + bj * 128 + n * 16);
#pragma unroll
        for (int ai = 0; ai < 2; ++ai)
#pragma unroll
            for (int m = 0; m < 4; ++m) { const int row = row0 + ai * 128 + m * 16; const size_t off = (size_t)row * DM + col0; float s = 0.f;
#pragma unroll
                for (int bj = 0; bj < 2; ++bj)
#pragma unroll
                    for (int n = 0; n < 2; ++n) { const f32x4 xv = *(const f32x4*)(x + off + bj * 128 + n * 16); const f32x4 o = xv + gv[bj][n] * acc[ai][bj][m][n];
                        *(f32x4*)(out + off + bj * 128 + n * 16) = o; s += (o.x * o.x + o.y * o.y) + (o.z * o.z + o.w * o.w); }
                s += __shfl_xor(s, 16); s += __shfl_xor(s, 32);
                if (fq == 0) ssq[(size_t)row * 32 + u.pn * 4 + wc] = s; }
    }
};

struct SchedMoe {
    const unsigned* slottok; const char* A; const char* B; const LAS int* tab; int G, c, shift; size_t b_estep, b_tstep, a_tstep;
    __device__ __forceinline__ bool next(int i, pg8::Unit& u) const {
        const int L = i * G + c; if (L >= (tab[16] << shift)) return false;
        const int tile = L >> shift; u.pn = L & ((1 << shift) - 1); int e = 0; while (tab[e + 1] <= tile) ++e;
        u.pm = tile; u.kind = e; u.aux = tile - tab[e];
        u.A = A + (size_t)tile * a_tstep; u.B = B + (size_t)e * b_estep + (size_t)u.pn * b_tstep; return true;
    }
    __device__ __forceinline__ int row_of(const pg8::Unit& u, int r) const { const int sl = u.aux * 256 + r; return sl < tab[32 + u.kind] ? (int)(slottok[u.kind * 16384 + sl] & 0xffffu) : 0; }
};
struct EpiSwiglu {
    static constexpr bool CHAIN = false;
    bf16* ACT;
    __device__ __forceinline__ void operator()(f32x4 (&acc)[2][2][4][2], const pg8::Unit& u, int wr, int wc, int fr, int fq) const {
        const int row0 = u.pm * 256 + wr * 64 + fr, col0 = u.pn * 128 + wc * 32 + 8 * fq;
#pragma unroll
        for (int ai = 0; ai < 2; ++ai)
#pragma unroll
            for (int m = 0; m < 4; ++m) { f32x4 v0, v1;
#pragma unroll
                for (int j = 0; j < 4; ++j) { const float g0 = acc[ai][0][m][0][j], g1 = acc[ai][0][m][1][j];
                    v0[j] = g0 * sigmoid_f(g0) * acc[ai][1][m][0][j]; v1[j] = g1 * sigmoid_f(g1) * acc[ai][1][m][1][j]; }
                u32x4 w; w.x = cvt_pk_bf16(v0[0], v0[1]); w.y = cvt_pk_bf16(v0[2], v0[3]); w.z = cvt_pk_bf16(v1[0], v1[1]); w.w = cvt_pk_bf16(v1[2], v1[3]);
                *(u32x4*)(ACT + (size_t)(row0 + ai * 128 + m * 16) * DE + col0) = w; }
    }
};
struct EpiDown {
    static constexpr bool CHAIN = false;
    const unsigned* slottok; const float* slotw; const LAS int* tab; bf16 *O0, *O1;
    __device__ __forceinline__ void operator()(f32x4 (&acc)[2][2][4][2], const pg8::Unit& u, int wr, int wc, int fr, int fq) const {
        const int e = u.kind, cnt = tab[32 + e], col0 = u.pn * 256 + wc * 32 + 8 * fq;
#pragma unroll
        for (int ai = 0; ai < 2; ++ai)
#pragma unroll
            for (int m = 0; m < 4; ++m) { const int sl = u.aux * 256 + ai * 128 + wr * 64 + m * 16 + fr;
                if (sl < cnt) { const unsigned info = slottok[e * 16384 + sl]; const float w = slotw[e * 16384 + sl];
                    bf16* dst = ((info >> 16) ? O1 : O0) + (size_t)(info & 0xffffu) * DM + col0;
#pragma unroll
                    for (int bj = 0; bj < 2; ++bj) { const f32x4 v0 = acc[ai][bj][m][0] * w, v1 = acc[ai][bj][m][1] * w;
                        u32x4 o; o.x = cvt_pk_bf16(v0[0], v0[1]); o.y = cvt_pk_bf16(v0[2], v0[3]); o.z = cvt_pk_bf16(v1[0], v1[1]); o.w = cvt_pk_bf16(v1[2], v1[3]);
                        *(u32x4*)(dst + bj * 128) = o; } } }
    }
};

__device__ __forceinline__ int list_base(int b, int h, int j) { return (b * 8 + h) * LIST_PER_BH + 256 * (32 * j - (j * (j - 1)) / 2); }

__device__ __forceinline__ void sgu_unit(Frame& F, int b, int c, int half) {
    LAS float* st = (LAS float*)F.lds;
    LAS bf16* vnT = (LAS bf16*)(F.lds + 1024);
    const int r0 = b * SEQ + c * 128;
    const bf16* VG = (const bf16*)(F.ws + WS_VG); const bf16* U = (const bf16*)(F.ws + WS_U); bf16* YSG = (bf16*)(F.ws + WS_YSG);
    for (int rr = 0; rr < 16; ++rr) { const int row = F.wave * 16 + rr;
        const u32x4* p = (const u32x4*)(VG + (size_t)(r0 + row) * DSG) + F.lane * 2;
        const u32x4 a = p[0], q = p[1]; float s = 0.f, ss = 0.f;
        const unsigned wv[8] = {a.x, a.y, a.z, a.w, q.x, q.y, q.z, q.w};
#pragma unroll
        for (int e = 0; e < 8; ++e) { const float lo = bf_lo(wv[e]), hi = bf_hi(wv[e]); s += lo + hi; ss += lo * lo + hi * hi; }
        s = wave_sum(s); ss = wave_sum(ss);
        const float mean = s * (1.0f / DSG), var = fmaxf(ss * (1.0f / DSG) - mean * mean, 0.f);
        if (F.lane == 0) { st[row * 2] = mean; st[row * 2 + 1] = 1.0f / sqrtf(var + EPS); } }
    __syncthreads();
    for (int gi = 0; gi < 4; ++gi) { const int g = half * 4 + gi;
        { const int s = F.tid >> 2, dq = F.tid & 3; const float mean = st[s * 2], rstd = st[s * 2 + 1];
          const bf16* src = VG + (size_t)(r0 + s) * DSG + g * 128 + dq * 32;
#pragma unroll
          for (int v4 = 0; v4 < 4; ++v4) { const u32x4 w = *(const u32x4*)(src + v4 * 8); const unsigned wv[4] = {w.x, w.y, w.z, w.w};
              const int colb = g * 128 + dq * 32 + v4 * 8;
              const f32x4 lw0 = *(const f32x4*)(F.sg_ln_w + colb), lw1 = *(const f32x4*)(F.sg_ln_w + colb + 4), lb0 = *(const f32x4*)(F.sg_ln_b + colb), lb1 = *(const f32x4*)(F.sg_ln_b + colb + 4);
              const float lw[8] = {lw0.x, lw0.y, lw0.z, lw0.w, lw1.x, lw1.y, lw1.z, lw1.w}, lb[8] = {lb0.x, lb0.y, lb0.z, lb0.w, lb1.x, lb1.y, lb1.z, lb1.w};
#pragma unroll
              for (int e = 0; e < 4; ++e) { const float x0 = bf_lo(wv[e]), x1 = bf_hi(wv[e]);
                  const float n0 = (x0 - mean) * rstd * lw[2 * e] + lb[2 * e], n1 = (x1 - mean) * rstd * lw[2 * e + 1] + lb[2 * e + 1];
                  const unsigned pk = cvt_pk_bf16(n0, n1);
                  vnT[(dq * 32 + v4 * 8 + 2 * e) * 136 + s] = (bf16)(pk & 0xffffu); vnT[(dq * 32 + v4 * 8 + 2 * e + 1) * 136 + s] = (bf16)(pk >> 16); } } }
        __syncthreads();
        { const int t0 = F.wave * 16, cl = F.lane & 15, g4 = F.lane >> 4, t = t0 + cl, nks = (t0 + 15) / 32 + 1;
          bf16x8 wf[4];
#pragma unroll
          for (int ks = 0; ks < 4; ++ks) { u32x4 pk = {0u, 0u, 0u, 0u};
              if (ks < nks) { const int s0 = ks * 32 + 8 * g4; const float* wp = F.w_spatial + ((size_t)(g * 128 + t)) * 128 + s0;
                  const f32x4 w0 = *(const f32x4*)wp, w1 = *(const f32x4*)(wp + 4);
                  float wv[8] = {w0.x, w0.y, w0.z, w0.w, w1.x, w1.y, w1.z, w1.w};
#pragma unroll
                  for (int jj = 0; jj < 8; ++jj) wv[jj] = (s0 + jj <= t) ? wv[jj] : 0.f;
                  pk.x = cvt_pk_bf16(wv[0], wv[1]); pk.y = cvt_pk_bf16(wv[2], wv[3]); pk.z = cvt_pk_bf16(wv[4], wv[5]); pk.w = cvt_pk_bf16(wv[6], wv[7]); }
              wf[ks] = __builtin_bit_cast(bf16x8, pk); }
          const float bias = F.b_spatial[g * 128 + t];
#pragma unroll
          for (int db = 0; db < 8; ++db) { f32x4 acc = {0.f, 0.f, 0.f, 0.f};
#pragma unroll
              for (int ks = 0; ks < 4; ++ks) if (ks < nks) { const bf16x8 a = *(const LAS bf16x8*)(vnT + (db * 16 + cl) * 136 + ks * 32 + 8 * g4); acc = __builtin_amdgcn_mfma_f32_16x16x32_bf16(a, wf[ks], acc, 0, 0, 0); }
              const size_t off = (size_t)(r0 + t) * DSG + g * 128 + db * 16 + 4 * g4;
              const u32x2 uu = *(const u32x2*)(U + off);
              u32x2 o; o.x = cvt_pk_bf16(bf_lo(uu.x) * (acc[0] + bias), bf_hi(uu.x) * (acc[1] + bias)); o.y = cvt_pk_bf16(bf_lo(uu.y) * (acc[2] + bias), bf_hi(uu.y) * (acc[3] + bias));
              *(u32x2*)(YSG + off) = o; } }
        __syncthreads();
    }
}

__device__ __forceinline__ void select_unit(Frame& F, int b, int h, int i) {
    LAS float* ks = (LAS float*)F.lds;
    LAS int* lcnt = (LAS int*)(F.lds + 16384); LAS int* gbase = lcnt + 32;
    const float* ksum = (const float*)(F.ctl + CW_KSUM) + (size_t)(b * 8 + h) * 32 * 128;
    unsigned* acnt = F.ctl + CW_ACNT + (b * 8 + h) * 32;
    unsigned* lists = (unsigned*)(F.ws + WS_LISTS); f32x2* ML = (f32x2*)(F.ws + WS_ML);
    for (int idx = F.tid; idx < i * 128; idx += NTHR) ks[idx] = ksum[idx];
    if (F.tid < 32) lcnt[F.tid] = 0;
    __syncthreads();
    const int q = F.tid >> 1, half = F.tid & 1, s = i * 256 + q;
    const bf16* Qrow = (const bf16*)(F.ws + WS_Q) + (size_t)(b * SEQ + s) * DATT + h * 128 + half * 64;
    float qv[64];
#pragma unroll
    for (int v = 0; v < 8; ++v) { const u32x4 w = *(const u32x4*)(Qrow + v * 8);
        qv[v * 8 + 0] = bf_lo(w.x); qv[v * 8 + 1] = bf_hi(w.x); qv[v * 8 + 2] = bf_lo(w.y); qv[v * 8 + 3] = bf_hi(w.y); qv[v * 8 + 4] = bf_lo(w.z); qv[v * 8 + 5] = bf_hi(w.z); qv[v * 8 + 6] = bf_lo(w.w); qv[v * 8 + 7] = bf_hi(w.w); }
    float s1 = -INFINITY, s2 = -INFINITY, s3 = -INFINITY; int j1 = 0, j2 = 0, j3 = 0;
    for (int j = 0; j < i; ++j) { const LAS f32x4* kp = (const LAS f32x4*)(ks + j * 128 + half * 64); float d = 0.f;
#pragma unroll
        for (int v = 0; v < 16; ++v) { const f32x4 kk = kp[v]; d += qv[4 * v] * kk.x; d += qv[4 * v + 1] * kk.y; d += qv[4 * v + 2] * kk.z; d += qv[4 * v + 3] * kk.w; }
        d += __shfl_xor(d, 1);
        if (d > s1) { s3 = s2; j3 = j2; s2 = s1; j2 = j1; s1 = d; j1 = j; } else if (d > s2) { s3 = s2; j3 = j2; s2 = d; j2 = j; } else if (d > s3) { s3 = d; j3 = j; } }
    const int nv = i < 3 ? i : 3;
    int pos0 = 0, pos1 = 0, pos2 = 0;
    if (half == 0) { if (nv > 0) pos0 = atomicAdd((int*)&lcnt[j1], 1); if (nv > 1) pos1 = atomicAdd((int*)&lcnt[j2], 1); if (nv > 2) pos2 = atomicAdd((int*)&lcnt[j3], 1); }
    __syncthreads();
    if (F.tid < 32) { const int n = lcnt[F.tid]; gbase[F.tid] = n > 0 ? (int)atomicAdd(acnt + F.tid, (unsigned)n) : 0; }
    __syncthreads();
    if (half == 0) {
        const size_t mlb = ((size_t)(b * 8 + h) * SEQ + s) * 4;
        if (nv > 0) lists[list_base(b, h, j1) + 256 + gbase[j1] + pos0] = ((unsigned)s << 2) | 0u; else ML[mlb + 0] = (f32x2){-1e30f, 0.f};
        if (nv > 1) lists[list_base(b, h, j2) + 256 + gbase[j2] + pos1] = ((unsigned)s << 2) | 1u; else ML[mlb + 1] = (f32x2){-1e30f, 0.f};
        if (nv > 2) lists[list_base(b, h, j3) + 256 + gbase[j3] + pos2] = ((unsigned)s << 2) | 2u; else ML[mlb + 2] = (f32x2){-1e30f, 0.f};
        lists[list_base(b, h, i) + q] = ((unsigned)s << 2) | 3u;
    }
    __syncthreads();
}

namespace att {
constexpr int KVBLK = 64;
constexpr int SHM_V = KVBLK * HD * 2, SHM_K = KVBLK * HD * 2;
constexpr int WS_OFF = 65536, LUT_OFF = 67584, PRE_OFF = 69888, OST_OFF = 72192, OST_WAVE = 8704, OST_STRIDE = 272;
constexpr float SCALE = 0.088388347648318440f;
constexpr float C = SCALE * LOG2E;
constexpr float THR2 = 11.5f;
#define KSWZ(row, colB) ((row) * 256 + ((colB) ^ (((row) & 7) << 4)))
#define SBAR() __builtin_amdgcn_sched_barrier(0)
__device__ __forceinline__ int crow(int r, int hi) { return (r & 3) + 8 * (r >> 2) + 4 * hi; }
__device__ __forceinline__ void partialSM(f32x16& p0, f32x16& p1, float& m_reg, float& mn, float& alpha, int relb, int hi, const LAS float* lut) {
    if (__all(relb - 63 >= 128)) { const float c31 = lut[512];
#pragma unroll
        for (int r = 0; r < 16; ++r) { p0[r] = fmaf(p0[r], C, c31); p1[r] = fmaf(p1[r], C, c31); } }
    else {
#pragma unroll
        for (int r = 0; r < 16; ++r) { const int rel = relb - crow(r, hi);
            const int i0 = min(max(rel + 1, 0), 512), i1 = min(max(rel - 31, 0), 512);
            p0[r] = fmaf(p0[r], C, lut[i0]); p1[r] = fmaf(p1[r], C, lut[i1]); } }
    float pmax = p0[0];
#pragma unroll
    for (int r = 1; r < 16; ++r) pmax = fmaxf(pmax, p0[r]);
#pragma unroll
    for (int r = 0; r < 16; ++r) pmax = fmaxf(pmax, p1[r]);
    { auto rr = __builtin_amdgcn_permlane32_swap(__float_as_uint(pmax), __float_as_uint(pmax), false, false);
      pmax = fmaxf(__uint_as_float(rr[0]), __uint_as_float(rr[1])); }
    if (__builtin_expect(__all(pmax - m_reg <= THR2), 1)) { mn = m_reg; alpha = 1.f; }
    else { mn = fmaxf(m_reg, pmax); alpha = __builtin_amdgcn_exp2f(m_reg - mn); m_reg = mn; }
#pragma unroll
    for (int r = 0; r < 16; ++r) { p0[r] -= mn; p1[r] -= mn; }
#pragma unroll
    for (int r = 0; r < 16; ++r) p0[r] = __builtin_amdgcn_exp2f(p0[r]);
}
__device__ __forceinline__ void finishSM(f32x16& p0, f32x16& p1, float alpha, float& l_reg, bf16x8& pa0, bf16x8& pa1, bf16x8& pa2, bf16x8& pa3) {
#pragma unroll
    for (int r = 0; r < 16; ++r) p1[r] = __builtin_amdgcn_exp2f(p1[r]);
    float ps = 0;
#pragma unroll
    for (int r = 0; r < 16; ++r) ps += p0[r];
#pragma unroll
    for (int r = 0; r < 16; ++r) ps += p1[r];
    { auto rr = __builtin_amdgcn_permlane32_swap(__float_as_uint(ps), __float_as_uint(ps), false, false);
      ps = __uint_as_float(rr[0]) + __uint_as_float(rr[1]); }
    l_reg = l_reg * alpha + ps;
#define PK4(P, BASE, OUT) do { unsigned a0 = cvt_pk_bf16(P[BASE + 0], P[BASE + 1]), a1 = cvt_pk_bf16(P[BASE + 2], P[BASE + 3]);   \
    unsigned b0 = cvt_pk_bf16(P[BASE + 4], P[BASE + 5]), b1 = cvt_pk_bf16(P[BASE + 6], P[BASE + 7]);                              \
    auto r0 = __builtin_amdgcn_permlane32_swap(a0, b0, false, false); auto r1 = __builtin_amdgcn_permlane32_swap(a1, b1, false, false); \
    u32x4 w = {r0[0], r1[0], r0[1], r1[1]}; OUT = __builtin_bit_cast(bf16x8, w); } while (0)
    PK4(p0, 0, pa0); PK4(p0, 8, pa1); PK4(p1, 0, pa2); PK4(p1, 8, pa3);
#undef PK4
}
__device__ __forceinline__ void qkt(f32x16& p0, f32x16& p1, const LAS char* Ks, const bf16x8* qr, int r32, int hi) {
    p0 = f32x16{}; p1 = f32x16{};
#pragma unroll
    for (int d0 = 0; d0 < 8; ++d0) { const int cb = (d0 * 16 + hi * 8) * 2;
        const bf16x8 b0 = *(const LAS bf16x8*)(Ks + KSWZ(r32, cb));
        const bf16x8 b1 = *(const LAS bf16x8*)(Ks + KSWZ(32 + r32, cb));
        p0 = __builtin_amdgcn_mfma_f32_32x32x16_bf16(b0, qr[d0], p0, 0, 0, 0);
        p1 = __builtin_amdgcn_mfma_f32_32x32x16_bf16(b1, qr[d0], p1, 0, 0, 0); }
}
__device__ __forceinline__ int v_st(int k, int c) { const int kk = (k & ~0xC) | ((k & 4) << 1) | ((k & 8) >> 1); return ((kk >> 3) * 4 + (c >> 5)) * 512 + ((kk & 7) * 32 + (c & 31)) * 2; }
__device__ __forceinline__ int v_rd_base(int lane) { return ((lane & 3) << 3) | (((lane >> 2) & 3) << 6) | (((lane >> 4) & 1) << 5) | (((lane >> 5) & 1) << 8); }
constexpr int v_rd_off(int d0, int ks, int half) { return d0 * 512 + ks * 4096 + half * 2048; }
template <int OFF> __device__ __forceinline__ s16x4 tr_read(int vb) {
    s16x4 r; asm volatile("ds_read_b64_tr_b16 %0, %1 offset:%2" : "=&v"(r) : "v"(vb), "i"(OFF) : "memory"); return r;
}
template <int D0> __device__ __forceinline__ void pv_one(f32x16& od, int vb, bf16x8 pa0, bf16x8 pa1, bf16x8 pa2, bf16x8 pa3) {
    const s16x4 l0 = tr_read<v_rd_off(D0, 0, 0)>(vb), h0 = tr_read<v_rd_off(D0, 0, 1)>(vb), l1 = tr_read<v_rd_off(D0, 1, 0)>(vb), h1 = tr_read<v_rd_off(D0, 1, 1)>(vb);
    const s16x4 l2 = tr_read<v_rd_off(D0, 2, 0)>(vb), h2 = tr_read<v_rd_off(D0, 2, 1)>(vb), l3 = tr_read<v_rd_off(D0, 3, 0)>(vb), h3 = tr_read<v_rd_off(D0, 3, 1)>(vb);
    asm volatile("s_waitcnt lgkmcnt(0)" ::: "memory"); SBAR();
#define PK(L, H) (bf16x8){L[0], L[1], L[2], L[3], H[0], H[1], H[2], H[3]}
    od = __builtin_amdgcn_mfma_f32_32x32x16_bf16(pa0, PK(l0, h0), od, 0, 0, 0);
    od = __builtin_amdgcn_mfma_f32_32x32x16_bf16(pa1, PK(l1, h1), od, 0, 0, 0);
    od = __builtin_amdgcn_mfma_f32_32x32x16_bf16(pa2, PK(l2, h2), od, 0, 0, 0);
    od = __builtin_amdgcn_mfma_f32_32x32x16_bf16(pa3, PK(l3, h3), od, 0, 0, 0);
#undef PK
}
__device__ __forceinline__ void pv_d0(f32x16* o, int vb, bf16x8 pa0, bf16x8 pa1, bf16x8 pa2, bf16x8 pa3) {
    pv_one<0>(o[0], vb, pa0, pa1, pa2, pa3); pv_one<1>(o[1], vb, pa0, pa1, pa2, pa3); pv_one<2>(o[2], vb, pa0, pa1, pa2, pa3); pv_one<3>(o[3], vb, pa0, pa1, pa2, pa3);
}

__device__ __forceinline__ void attn_tile(LAS char* lds, const int wid, const unsigned* list, int n, int ti, int b, int h, int j,
                                          const bf16* Qg, const bf16* Kg, const bf16* Vg, bf16* OP, f32x2* ML) {
    constexpr int LDK = DATT;
    int lane_ = lane_id(); asm volatile("" : "+v"(lane_));
    const int lane = lane_, tid = wid * 64 + lane, r32 = lane & 31, hi = lane >> 5;
    LAS char* V_lds = lds; LAS char* K_lds = lds + 2 * SHM_V;
    LAS float* wsf = (LAS float*)(lds + WS_OFF) + wid * 64; LAS float* li_l = wsf; LAS float* al_l = wsf + 32;
    const LAS float* lut = (const LAS float*)(lds + LUT_OFF);
    LAS char* ost = lds + OST_OFF + wid * OST_WAVE;
    const int pos = ti * 256 + wid * 32 + r32; const bool valid = pos < n;
    const unsigned entry = list[valid ? pos : n - 1];
    const int qpos = (int)(entry >> 2), pick = (int)(entry & 3u);
    const int relq = qpos - 256 * j;
    float m_reg = -1e30f, l_reg = 0; f32x16 o[4] = {}; bf16x8 qr[8];
    const bf16* Qw = Qg + (size_t)(b * SEQ + qpos) * DATT + h * HD + hi * 8;
#pragma unroll
    for (int d0 = 0; d0 < 8; ++d0) qr[d0] = *(const bf16x8*)(Qw + d0 * 16);
    const bf16* Kh = Kg + (size_t)(b * SEQ + 256 * j) * DATT + h * HD; const bf16* Vh = Vg + (size_t)(b * SEQ + 256 * j) * DATT + h * HD;
    const int sr = tid >> 4, sc = (tid & 15) * 8, vst0 = v_st(sr, sc), vst1 = v_st(32 + sr, sc);
    const int vb0 = (int)(uintptr_t)V_lds + v_rd_base(lane);
    struct { bf16x8 vs0, vs1, ks0, ks1; } sr_[2];
#define SLOAD(i, k0) do { sr_[i].vs0 = *(const bf16x8*)(&Vh[(size_t)((k0) + sr) * LDK + sc]); sr_[i].vs1 = *(const bf16x8*)(&Vh[(size_t)((k0) + 32 + sr) * LDK + sc]); \
    sr_[i].ks0 = *(const bf16x8*)(&Kh[(size_t)((k0) + sr) * LDK + sc]); sr_[i].ks1 = *(const bf16x8*)(&Kh[(size_t)((k0) + 32 + sr) * LDK + sc]); } while (0)
#define SWRITE(bb, i) do { *(LAS bf16x8*)(V_lds + (bb) * SHM_V + vst0) = sr_[i].vs0; *(LAS bf16x8*)(V_lds + (bb) * SHM_V + vst1) = sr_[i].vs1; const int kc = sc * 2; \
    *(LAS bf16x8*)(K_lds + (bb) * SHM_K + KSWZ(sr, kc)) = sr_[i].ks0; *(LAS bf16x8*)(K_lds + (bb) * SHM_K + KSWZ(32 + sr, kc)) = sr_[i].ks1; } while (0)
#define SWAIT() asm volatile("s_waitcnt vmcnt(4)" ::: "memory")
#define RESC(a) do { if (__any((a) < 1.f)) { if (hi == 0) al_l[r32] = (a); asm volatile("s_waitcnt lgkmcnt(0)" ::: "memory"); \
    _Pragma("unroll") for (int d = 0; d < 4; ++d) _Pragma("unroll") for (int r = 0; r < 16; ++r) o[d][r] *= al_l[crow(r, hi)]; } } while (0)
    f32x16 pA0, pA1, pB0, pB1; float mnA, mnB, alA, alB; bf16x8 pa0, pa1, pa2, pa3;
    __syncthreads();
    SLOAD(0, 0); asm volatile("s_waitcnt vmcnt(0)" ::: "memory"); SWRITE(0, 0); __syncthreads();
    qkt(pA0, pA1, K_lds, qr, r32, hi); partialSM(pA0, pA1, m_reg, mnA, alA, relq, hi, lut);
    SLOAD(1, KVBLK); SLOAD(0, 2 * KVBLK);
    SWAIT(); SWRITE(1, 1); __syncthreads();
    {
        SBAR(); qkt(pB0, pB1, K_lds + SHM_K, qr, r32, hi);
        finishSM(pA0, pA1, alA, l_reg, pa0, pa1, pa2, pa3); SBAR();
        SLOAD(1, 3 * KVBLK); SBAR();
        pv_d0(o, vb0, pa0, pa1, pa2, pa3); partialSM(pB0, pB1, m_reg, mnB, alB, relq - 64, hi, lut);
        __syncthreads(); SWAIT(); SWRITE(0, 0);
        RESC(alB); __syncthreads();
        SBAR(); qkt(pA0, pA1, K_lds, qr, r32, hi);
        finishSM(pB0, pB1, alB, l_reg, pa0, pa1, pa2, pa3); SBAR();
        pv_d0(o, vb0 + SHM_V, pa0, pa1, pa2, pa3); partialSM(pA0, pA1, m_reg, mnA, alA, relq - 128, hi, lut);
        __syncthreads(); asm volatile("s_waitcnt vmcnt(0)" ::: "memory"); SWRITE(1, 1);
        RESC(alA); __syncthreads();
    }
    SBAR(); qkt(pB0, pB1, K_lds + SHM_K, qr, r32, hi);
    finishSM(pA0, pA1, alA, l_reg, pa0, pa1, pa2, pa3); SBAR();
    pv_d0(o, vb0, pa0, pa1, pa2, pa3); partialSM(pB0, pB1, m_reg, mnB, alB, relq - 192, hi, lut);
    __syncthreads(); RESC(alB);
    finishSM(pB0, pB1, alB, l_reg, pa0, pa1, pa2, pa3); SBAR();
    pv_d0(o, vb0 + SHM_V, pa0, pa1, pa2, pa3);
    if (hi == 0) li_l[r32] = l_reg; asm volatile("s_waitcnt lgkmcnt(0)" ::: "memory");
#pragma unroll
    for (int r = 0; r < 16; ++r) { const int orow = crow(r, hi); const float rl = __builtin_amdgcn_rcpf(li_l[orow]);
#pragma unroll
        for (int d0 = 0; d0 < 4; ++d0) *(LAS bf16*)(ost + orow * OST_STRIDE + (d0 * 32 + r32) * 2) = (bf16)(cvt_pk_bf16(o[d0][r] * rl, 0.f) & 0xffffu); }
    asm volatile("s_waitcnt lgkmcnt(0)" ::: "memory");
    const size_t rowbase = (((size_t)(b * 8 + h) * SEQ + qpos) * 4 + pick);
    if (hi == 0 && valid) ML[rowbase] = (f32x2){m_reg, l_reg};
    { int lq = lane >> 4, lc = lane & 15; asm volatile("" : "+v"(lq), "+v"(lc));
      const LAS char* rbp = ost + lq * OST_STRIDE + lc * 16;
      const unsigned rbu = (unsigned)rowbase;
#pragma unroll
      for (int it = 0; it < 8; ++it) { const int row = it * 4 + lq;
        const unsigned rb = (unsigned)__shfl((int)rbu, row); const int vld = __shfl((int)valid, row);
        const u32x4 w = *(const LAS u32x4*)(rbp + it * 4 * OST_STRIDE);
        if (vld) *(u32x4*)(OP + (size_t)rb * HD + lc * 8) = w; } }
#undef SLOAD
#undef SWRITE
#undef SWAIT
#undef RESC
}
}

__device__ __forceinline__ void p3b_attention(Frame& F) {
    LAS char* lds = (LAS char*)F.lds;
    LAS int* pre = (LAS int*)(lds + att::PRE_OFF);
    LAS int* wtot = (LAS int*)(lds + att::WS_OFF);
    LAS float* lut = (LAS float*)(lds + att::LUT_OFF);
    const unsigned* acnt = F.ctl + CW_ACNT;
    {
        const int cnt = (int)acnt[F.tid]; int v = 1 + (cnt + 255) / 256;
#pragma unroll
        for (int o = 1; o < 64; o <<= 1) { const int t = __shfl_up(v, o); if (F.lane >= o) v += t; }
        if (F.lane == 63) wtot[F.wave] = v;
        __syncthreads();
        int offs = 0; for (int w = 0; w < F.wave; ++w) offs += wtot[w];
        pre[F.tid + 1] = offs + v; if (F.tid == 0) pre[0] = 0;
        __syncthreads();
    }
    const int T = pre[512];
    const int lo = (int)(((long)F.vcu * T) / F.G), hiT = (int)(((long)(F.vcu + 1) * T) / F.G);
    int curh = -1;
    for (int g = lo; g < hiT; ++g) {
        int a = 0, bnd = 512; while (bnd - a > 1) { const int mid = (a + bnd) >> 1; if (pre[mid] <= g) a = mid; else bnd = mid; }
        const int L = a, ti = g - pre[L], b = L >> 8, h = (L >> 5) & 7, j = L & 31, n = 256 + (int)acnt[L];
        if (h != curh) { __syncthreads(); curh = h;
            for (int idx = F.tid; idx < 513; idx += NTHR) { float v;
                if (idx == 0) v = -INFINITY;
                else { const int rel = idx - 1; int bk = rel;
                    if (rel >= 16) { bk = 16 + (int)(logf((float)rel * (1.0f / 16.0f)) / 2.0794415416798357f * 16.0f); bk = bk > 31 ? 31 : bk; }
                    v = F.rel_bias[bk * 8 + h] * LOG2E; }
                lut[idx] = v; }
        }
        att::attn_tile(lds, F.wave, (const unsigned*)(F.ws + WS_LISTS) + list_base(b, h, j), n, ti, b, h, j,
                       (const bf16*)(F.ws + WS_Q), (const bf16*)(F.ws + WS_K), (const bf16*)(F.ws + WS_V), (bf16*)(F.ws + WS_OPART), (f32x2*)(F.ws + WS_ML));
    }
    __syncthreads();
}

__device__ __forceinline__ void p3c_combine(Frame& F) {
    const int gw = F.vcu * NWAVES + F.wave, NGW = F.G * NWAVES;
    const bf16* OP = (const bf16*)(F.ws + WS_OPART); const f32x2* ML = (const f32x2*)(F.ws + WS_ML); bf16* YATT = (bf16*)(F.ws + WS_YATT);
    const int h = F.lane >> 3, dch = F.lane & 7;
    for (int m = gw; m < MTOK; m += NGW) { const int b = m / SEQ, s = m % SEQ;
        const size_t rb = ((size_t)(b * 8 + h) * SEQ + s) * 4;
        f32x2 ml[4]; float M = -1e30f;
#pragma unroll
        for (int p = 0; p < 4; ++p) { ml[p] = ML[rb + p]; if (ml[p].y > 0.f) M = fmaxf(M, ml[p].x); }
        float acc[16]; float wsum = 0.f;
#pragma unroll
        for (int e = 0; e < 16; ++e) acc[e] = 0.f;
#pragma unroll
        for (int p = 0; p < 4; ++p) if (ml[p].y > 0.f) { const float w = ml[p].y * __builtin_amdgcn_exp2f(ml[p].x - M); wsum += w;
            const u32x4* src = (const u32x4*)(OP + (rb + p) * HD + dch * 16); const u32x4 a = src[0], c = src[1];
            const unsigned wv[8] = {a.x, a.y, a.z, a.w, c.x, c.y, c.z, c.w};
#pragma unroll
            for (int e = 0; e < 8; ++e) { acc[2 * e] += w * bf_lo(wv[e]); acc[2 * e + 1] += w * bf_hi(wv[e]); } }
        const float inv = 1.0f / wsum;
        u32x4 o0, o1;
        o0.x = cvt_pk_bf16(acc[0] * inv, acc[1] * inv); o0.y = cvt_pk_bf16(acc[2] * inv, acc[3] * inv); o0.z = cvt_pk_bf16(acc[4] * inv, acc[5] * inv); o0.w = cvt_pk_bf16(acc[6] * inv, acc[7] * inv);
        o1.x = cvt_pk_bf16(acc[8] * inv, acc[9] * inv); o1.y = cvt_pk_bf16(acc[10] * inv, acc[11] * inv); o1.z = cvt_pk_bf16(acc[12] * inv, acc[13] * inv); o1.w = cvt_pk_bf16(acc[14] * inv, acc[15] * inv);
        u32x4* dst = (u32x4*)(YATT + (size_t)m * DATT + h * HD + dch * 16); dst[0] = o0; dst[1] = o1; }
}

__device__ __forceinline__ void p6_route(Frame& F) {
    {
        LAS float* scr = (LAS float*)(F.lds + F.wave * 16384);
        const int gw = F.vcu * NWAVES + F.wave, NGW = F.G * NWAVES;
        bf16* W13T = (bf16*)(F.ws + WS_W13T); bf16* W2T = (bf16*)(F.ws + WS_W2T);
        for (int it = gw; it < 3 * 8192; it += NGW) {
            const int which = it >> 13, r = it & 8191, e = r >> 9, q = r & 511;
            if (which < 2) { const int kb = q >> 4, nb = q & 15, n0 = 32 * nb;
                transpose_item((which ? F.w_eu : F.w_eg) + (size_t)e * DM * DE, DE, W13T, DM, 64 * kb, n0, e * 1024 + 256 * (n0 >> 7) + which * 128 + (n0 & 127), scr, F.lane); }
            else { const int kb = q >> 6, nb = q & 63;
                transpose_item(F.w_ed + (size_t)e * DE * DM, DM, W2T, DE, 64 * kb, 32 * nb, e * 2048 + 32 * nb, scr, F.lane); }
        }
    }
    __syncthreads();
    LAS float* pbuf = (LAS float*)F.lds;
    LAS float* lg = (LAS float*)(F.lds + 16384);
    LAS int* lcnt = (LAS int*)(F.lds + 24576); LAS int* gb = lcnt + 16;
    LAS float* rinfo = (LAS float*)(F.lds + 24832);
    const float* x1 = F.out; const float* SSQ = (const float*)(F.ws + WS_SSQ); const float* A2 = (const float*)(F.ws + WS_A2);
    const float* mod = (const float*)(F.ws + WS_MOD); const bf16* WR = (const bf16*)(F.ws + WS_WR); const float* RC = (const float*)(F.ws + WS_RCONST);
    bf16* H2 = (bf16*)(F.ws + WS_H2);
    for (int rb = F.vcu * 64; rb < MTOK; rb += F.G * 64) {
        const int bk = F.wave >> 1, kh = F.wave & 1, r = F.lane & 15, g4 = F.lane >> 4, row = rb + bk * 16 + r, b = row / SEQ;
        if (F.tid < 16) lcnt[F.tid] = 0;
        float rstd;
        { const f32x4 s0 = *(const f32x4*)(SSQ + (size_t)row * 32 + g4 * 8), s1 = *(const f32x4*)(SSQ + (size_t)row * 32 + g4 * 8 + 4);
          float s = ((s0.x + s0.y) + (s0.z + s0.w)) + ((s1.x + s1.y) + (s1.z + s1.w)); s += __shfl_xor(s, 16); s += __shfl_xor(s, 32);
          rstd = 1.0f / sqrtf(s * (1.0f / DM) + EPS); }
        f32x4 acc0 = {0.f, 0.f, 0.f, 0.f}, acc1 = {0.f, 0.f, 0.f, 0.f};
        const float* xr = x1 + (size_t)row * DM; const float* a2p = A2 + b * DM; const float* shp = mod + b * (6 * DM) + 3 * DM;
        const bf16* wh0 = WR + ((size_t)(b * 2 + 0) * 32 + r) * DM, * wl0 = WR + ((size_t)(b * 2 + 1) * 32 + r) * DM;
        for (int it = 0; it < 32; ++it) { const int kk = kh * 1024 + it * 32 + 8 * g4;
            const f32x4 xa = *(const f32x4*)(xr + kk), xb = *(const f32x4*)(xr + kk + 4);
            const f32x4 aa = *(const f32x4*)(a2p + kk), ab = *(const f32x4*)(a2p + kk + 4), sa = *(const f32x4*)(shp + kk), sb = *(const f32x4*)(shp + kk + 4);
            const f32x4 ha = xa * rstd * aa + sa, hb = xb * rstd * ab + sb;
            u32x4 hw; hw.x = cvt_pk_bf16(ha.x, ha.y); hw.y = cvt_pk_bf16(ha.z, ha.w); hw.z = cvt_pk_bf16(hb.x, hb.y); hw.w = cvt_pk_bf16(hb.z, hb.w);
            *(u32x4*)(H2 + (size_t)row * DM + kk) = hw;
            u32x4 xh; xh.x = cvt_pk_bf16(xa.x, xa.y); xh.y = cvt_pk_bf16(xa.z, xa.w); xh.z = cvt_pk_bf16(xb.x, xb.y); xh.w = cvt_pk_bf16(xb.z, xb.w);
            u32x4 xl; xl.x = cvt_pk_bf16(xa.x - bf_lo(xh.x), xa.y - bf_hi(xh.x)); xl.y = cvt_pk_bf16(xa.z - bf_lo(xh.y), xa.w - bf_hi(xh.y));
            xl.z = cvt_pk_bf16(xb.x - bf_lo(xh.z), xb.y - bf_hi(xh.z)); xl.w = cvt_pk_bf16(xb.z - bf_lo(xh.w), xb.w - bf_hi(xh.w));
            const bf16x8 ah = __builtin_bit_cast(bf16x8, xh), al = __builtin_bit_cast(bf16x8, xl);
            const bf16x8 bh0 = *(const bf16x8*)(wh0 + kk), bl0 = *(const bf16x8*)(wl0 + kk), bh1 = *(const bf16x8*)(wh0 + 16 * DM + kk), bl1 = *(const bf16x8*)(wl0 + 16 * DM + kk);
            acc0 = __builtin_amdgcn_mfma_f32_16x16x32_bf16(ah, bh0, acc0, 0, 0, 0); acc0 = __builtin_amdgcn_mfma_f32_16x16x32_bf16(al, bh0, acc0, 0, 0, 0); acc0 = __builtin_amdgcn_mfma_f32_16x16x32_bf16(ah, bl0, acc0, 0, 0, 0);
            acc1 = __builtin_amdgcn_mfma_f32_16x16x32_bf16(ah, bh1, acc1, 0, 0, 0); acc1 = __builtin_amdgcn_mfma_f32_16x16x32_bf16(al, bh1, acc1, 0, 0, 0); acc1 = __builtin_amdgcn_mfma_f32_16x16x32_bf16(ah, bl1, acc1, 0, 0, 0);
        }
#pragma unroll
        for (int e = 0; e < 4; ++e) { pbuf[((bk * 2 + kh) * 16 + 4 * g4 + e) * 32 + r] = acc0[e]; pbuf[((bk * 2 + kh) * 16 + 4 * g4 + e) * 32 + 16 + r] = acc1[e]; }
        __syncthreads();
        if (kh == 0 && F.lane < 16) {
            const int lrow = bk * 16 + F.lane;
            for (int c = 0; c < 20; ++c) lg[lrow * 32 + c] = rstd * (pbuf[((bk * 2 + 0) * 16 + F.lane) * 32 + c] + pbuf[((bk * 2 + 1) * 16 + F.lane) * 32 + c]) + RC[b * 32 + c];
            int gi = 0; float gm = lg[lrow * 32];
            for (int c = 1; c < 4; ++c) { const float v = lg[lrow * 32 + c]; if (v > gm) { gm = v; gi = c; } }
            float gs = 0.f; for (int c = 0; c < 4; ++c) gs += expf(lg[lrow * 32 + c] - gm);
            const float gp = 1.0f / gs;
            const LAS float* el = lg + lrow * 32 + 4 + 4 * gi;
            int i0 = 0; float m0 = el[0]; for (int c = 1; c < 4; ++c) if (el[c] > m0) { m0 = el[c]; i0 = c; }
            int i1 = -1; float m1 = -INFINITY; for (int c = 0; c < 4; ++c) if (c != i0 && el[c] > m1) { m1 = el[c]; i1 = c; }
            const float t = expf(m1 - m0), w0 = gp / (1.0f + t), w1 = gp * t / (1.0f + t);
            const int e0 = 4 * gi + i0, e1 = 4 * gi + i1;
            const int p0 = atomicAdd((int*)&lcnt[e0], 1), p1 = atomicAdd((int*)&lcnt[e1], 1);
            LAS float* ri = rinfo + lrow * 8; ri[0] = __int_as_float(e0); ri[1] = __int_as_float(p0); ri[2] = w0; ri[3] = __int_as_float(e1); ri[4] = __int_as_float(p1); ri[5] = w1;
        }
        __syncthreads();
        if (F.tid < 16) { const int n = lcnt[F.tid]; gb[F.tid] = n > 0 ? (int)atomicAdd(F.ctl + CW_ECNT + 64 * F.tid, (unsigned)n) : 0; }
        __syncthreads();
        if (F.tid < 64) { const LAS float* ri = rinfo + F.tid * 8; const unsigned tok = (unsigned)(rb + F.tid);
            unsigned* ST = (unsigned*)(F.ws + WS_SLOTTOK); float* SW = (float*)(F.ws + WS_SLOTW);
            const int e0 = __float_as_int(ri[0]), e1 = __float_as_int(ri[3]);
            const int s0 = e0 * 16384 + gb[e0] + __float_as_int(ri[1]), s1 = e1 * 16384 + gb[e1] + __float_as_int(ri[4]);
            ST[s0] = tok; SW[s0] = ri[2]; ST[s1] = tok | 0x10000u; SW[s1] = ri[5]; }
        __syncthreads();
    }
}

__device__ __forceinline__ void moe_table(Frame& F, LAS int* tab) {
    __syncthreads();
    if (F.tid == 0) { int acc = 0; for (int e = 0; e < 16; ++e) { const int n = (int)F.ctl[CW_ECNT + 64 * e]; tab[e] = acc; tab[32 + e] = n; acc += (n + 255) >> 8; } tab[16] = acc; }
    __syncthreads();
}

__device__ __forceinline__ void p9_final(Frame& F) {
    const int gw = F.vcu * NWAVES + F.wave, NGW = F.G * NWAVES;
    const float* mod = (const float*)(F.ws + WS_MOD); const bf16* O0 = (const bf16*)(F.ws + WS_O0); const bf16* O1 = (const bf16*)(F.ws + WS_O1);
    int curb = -1; f32x4 gv[8], fw[8];
#pragma unroll
    for (int j = 0; j < 8; ++j) fw[j] = *(const f32x4*)(F.final_w + 4 * F.lane + 256 * j);
    for (int m = gw; m < MTOK; m += NGW) {
        const int b = m / SEQ;
        if (b != curb) { curb = b;
#pragma unroll
            for (int j = 0; j < 8; ++j) gv[j] = *(const f32x4*)(mod + b * (6 * DM) + 5 * DM + 4 * F.lane + 256 * j); }
        f32x4* xr = (f32x4*)(F.out + (size_t)m * DM) + F.lane;
        const u32x2* p0 = (const u32x2*)(O0 + (size_t)m * DM) + F.lane; const u32x2* p1 = (const u32x2*)(O1 + (size_t)m * DM) + F.lane;
        f32x4 v[8]; float s = 0.f;
#pragma unroll
        for (int j = 0; j < 8; ++j) { const u32x2 a = p0[64 * j], c = p1[64 * j];
            const f32x4 y = {bf_lo(a.x) + bf_lo(c.x), bf_hi(a.x) + bf_hi(c.x), bf_lo(a.y) + bf_lo(c.y), bf_hi(a.y) + bf_hi(c.y)};
            v[j] = xr[64 * j] + gv[j] * y; s += (v[j].x * v[j].x + v[j].y * v[j].y) + (v[j].z * v[j].z + v[j].w * v[j].w); }
        const float rstd = 1.0f / sqrtf(wave_sum(s) * (1.0f / DM) + EPS);
#pragma unroll
        for (int j = 0; j < 8; ++j) xr[64 * j] = v[j] * rstd * fw[j];
    }
}

constexpr int N_PHASES = 12;
struct Args { const float* in[21]; float* out; unsigned char* ws; int ph_lo, ph_hi; };
__global__ void __launch_bounds__(NTHR, 2) fwd_kernel(Args args) {
    extern __shared__ __attribute__((aligned(16))) unsigned char lds_raw[];
    Frame F;
    F.lds = (LAS unsigned char*)lds_raw; F.MISC = (volatile LAS unsigned*)(F.lds + MISC_OFF);
    F.wave = __builtin_amdgcn_readfirstlane(threadIdx.x >> 6); F.lane = lane_id(); F.tid = F.wave * 64 + F.lane;
    F.G = gridDim.x; { const int bx = blockIdx.x; F.vcu = (F.G % 8 == 0) ? (bx % 8) * (F.G / 8) + bx / 8 : bx; }
    F.ws = args.ws; F.ctl = (unsigned*)(args.ws + WS_CTL); F.out = args.out;
    F.x = args.in[0]; F.c = args.in[1]; F.w_ada = args.in[2]; F.b_ada = args.in[3]; F.norm1_w = args.in[4]; F.norm2_w = args.in[5]; F.final_w = args.in[6]; F.w_in = args.in[7];
    F.sg_ln_w = args.in[8]; F.sg_ln_b = args.in[9]; F.w_spatial = args.in[10]; F.b_spatial = args.in[11]; F.rel_bias = args.in[12]; F.w_out_sg = args.in[13]; F.w_out_att = args.in[14];
    F.w_o = args.in[15]; F.w_rg = args.in[16]; F.w_re = args.in[17]; F.w_eg = args.in[18]; F.w_eu = args.in[19]; F.w_ed = args.in[20];
    for (int u = F.tid; u < (LDS_BYTES - MISC_OFF) / 4; u += NTHR) ((LAS unsigned*)(F.lds + MISC_OFF))[u] = 0u;
    __syncthreads();
    const int lo = args.ph_lo, hi = args.ph_hi;
    XcdBarrier bar; bar.bar = F.ctl + CW_BAR; bar.x = 0; bar.st = nullptr; bar.wid = F.wave;
    if (hi - lo > 1) bar = xcd_barrier_post(F.ctl + CW_BAR, F.MISC + 8, F.wave);
#ifndef PHASE_MASK
#define PHASE_MASK 0xFFF
#endif
#define IN(k) (((PHASE_MASK >> (k)) & 1) && lo <= (k) && (k) < hi && ((F.lane = lane_id()), (F.tid = F.wave * 64 + F.lane), true))
#define SEAM(k) do { if (IN(k) && IN((k) + 1)) xcd_barrier(bar); } while (0)
    LAS int* tab = (LAS int*)(F.lds + TAB_OFF);

    if (IN(0)) { p0_prologue(F); } SEAM(0);
    if (IN(1)) { p1_norm1(F); } SEAM(1);
    if (IN(2)) {
        SchedGrid S{(const char*)(F.ws + WS_H), (const char*)(F.ws + WS_WINT), 36, 64 * 36, F.G, F.vcu, (size_t)256 * DM * 2, (size_t)256 * DM * 2};
        EpiProj E{F.ws, (float*)(F.ctl + CW_KSUM)};
        pg8::gemm_phase<DM, true, false>(F.lds, F.wave, S, E);
    } SEAM(2);
    if (IN(3)) {
        for (int u = F.vcu; u < 256; u += F.G) sgu_unit(F, u >> 7, (u >> 1) & 63, u & 1);
        for (int u = F.vcu; u < 512; u += F.G) { const int i5 = u & 31; select_unit(F, u >> 8, (u >> 5) & 7, (u & 256) ? 31 - i5 : i5); }
    } SEAM(3);
    if (IN(4)) { p3b_attention(F); } SEAM(4);
    if (IN(5)) { p3c_combine(F); } SEAM(5);
    if (IN(6)) {
        SchedPair S{(const char*)(F.ws + WS_YSG), (const char*)(F.ws + WS_YATT), (const char*)(F.ws + WS_WOSGT), (const char*)(F.ws + WS_WOATTT), F.G, F.vcu};
        EpiMerge E{(const bf16*)(F.ws + WS_GS), (const bf16*)(F.ws + WS_GA), (bf16*)(F.ws + WS_MERGED)};
        pg8::gemm_phase<1024, true, false>(F.lds, F.wave, S, E);
    } SEAM(6);
    if (IN(7)) {
        SchedGrid S{(const char*)(F.ws + WS_MERGED), (const char*)(F.ws + WS_WOT), 8, 64 * 8, F.G, F.vcu, (size_t)256 * DM * 2, (size_t)256 * DM * 2};
        EpiX1 E{F.x, (const float*)(F.ws + WS_MOD), F.out, (float*)(F.ws + WS_SSQ)};
        pg8::gemm_phase<DM, false, false>(F.lds, F.wave, S, E);
    } SEAM(7);
    if (IN(8)) { p6_route(F); } SEAM(8);
    if (IN(9)) {
        moe_table(F, tab);
        SchedMoe S{(const unsigned*)(F.ws + WS_SLOTTOK), (const char*)(F.ws + WS_H2), (const char*)(F.ws + WS_W13T), tab, F.G, F.vcu, 2, (size_t)1024 * DM * 2, (size_t)256 * DM * 2, 0};
        EpiSwiglu E{(bf16*)(F.ws + WS_ACT)};
        pg8::gemm_phase<DM, true, true>(F.lds, F.wave, S, E);
    } SEAM(9);
    if (IN(10)) {
        moe_table(F, tab);
        SchedMoe S{(const unsigned*)(F.ws + WS_SLOTTOK), (const char*)(F.ws + WS_ACT), (const char*)(F.ws + WS_W2T), tab, F.G, F.vcu, 3, (size_t)DM * DE * 2, (size_t)256 * DE * 2, (size_t)256 * DE * 2};
        EpiDown E{(const unsigned*)(F.ws + WS_SLOTTOK), (const float*)(F.ws + WS_SLOTW), tab, (bf16*)(F.ws + WS_O0), (bf16*)(F.ws + WS_O1)};
        pg8::gemm_phase<DE, true, false>(F.lds, F.wave, S, E);
    } SEAM(10);
    if (IN(11)) { p9_final(F); }
#undef IN
#undef SEAM
}

extern "C" void kernel_launch(void* const* d_in, const int* in_sizes, int n_in, void* d_out, int out_size, void* d_ws, size_t ws_size, hipStream_t stream) {
    static int grid = 0;
    if (grid == 0) {
        if (n_in != 21 || in_sizes[0] != MTOK * DM || out_size != MTOK * DM || ws_size < WS_END) {
            fprintf(stderr, "kernel_launch: unexpected shapes (n_in %d, in0 %d, out %d, ws %zu, need ws >= %zu); nothing launched\n", n_in, n_in > 0 ? in_sizes[0] : -1, out_size, ws_size, (size_t)WS_END); grid = -1; return; }
        int dev = 0, cus = 0, per_cu = 0;
        if (hipGetDevice(&dev) != hipSuccess || hipDeviceGetAttribute(&cus, hipDeviceAttributeMultiprocessorCount, dev) != hipSuccess) { grid = -1; return; }
        if (hipFuncSetAttribute((const void*)fwd_kernel, hipFuncAttributeMaxDynamicSharedMemorySize, LDS_BYTES) != hipSuccess) { fprintf(stderr, "kernel_launch: hipFuncSetAttribute failed\n"); grid = -1; return; }
        if (hipOccupancyMaxActiveBlocksPerMultiprocessor(&per_cu, (const void*)fwd_kernel, NTHR, LDS_BYTES) != hipSuccess || per_cu < 1) { fprintf(stderr, "kernel_launch: occupancy query says %d\n", per_cu); }
        (void)hipGetLastError();
        grid = cus;
    }
    if (grid < 0) return;
    if (hipMemsetAsync((char*)d_ws + WS_CTL, 0, CTL_ZERO_BYTES, stream) != hipSuccess) return;
    Args a{};
    for (int i = 0; i < 21; ++i) a.in[i] = (const float*)d_in[i];
    a.out = (float*)d_out; a.ws = (unsigned char*)d_ws;
#if MK_N_LAUNCHES == 1
    a.ph_lo = 0; a.ph_hi = N_PHASES;
    hipLaunchKernelGGL(fwd_kernel, dim3(grid), dim3(NTHR), LDS_BYTES, stream, a);
#else
    for (int p = 0; p < N_PHASES; ++p) { a.ph_lo = p; a.ph_hi = p + 1; hipLaunchKernelGGL(fwd_kernel, dim3(grid), dim3(NTHR), LDS_BYTES, stream, a); }
#endif
    const hipError_t le = hipPeekAtLastError();
    if (le != hipSuccess) fprintf(stderr, "kernel_launch: launch failed: %s\n", hipGetErrorName(le));
}
```

```cpp
#include <hip/hip_runtime.h>
#include <cstdio>
#include <cstdint>

#ifndef MK_N_LAUNCHES
#define MK_N_LAUNCHES 1
#endif

#define GAS __attribute__((address_space(1)))
#define LAS __attribute__((address_space(3)))
typedef unsigned short bf16;
typedef short bf16x8 __attribute__((ext_vector_type(8)));
typedef short s16x4 __attribute__((ext_vector_type(4)));
typedef float f32x2 __attribute__((ext_vector_type(2)));
typedef float f32x4 __attribute__((ext_vector_type(4)));
typedef float f32x16 __attribute__((ext_vector_type(16)));
typedef unsigned u32x2 __attribute__((ext_vector_type(2)));
typedef unsigned u32x4 __attribute__((ext_vector_type(4)));

constexpr int BATCH = 2, SEQ = 8192, DM = 2048, MTOK = BATCH * SEQ;
constexpr int DSG = 1024, DATT = 1024, NH = 8, HD = 128, NBLK = 32, INCOLS = 9216;
constexpr int NE = 16, DE = 512;
constexpr float EPS = 1e-6f;
constexpr float LOG2E = 1.4426950408889634f;
constexpr int NWAVES = 8, NTHR = 512;

constexpr size_t MiB = 1u << 20;
constexpr size_t WS_CTL = 0, CTL_ZERO_BYTES = 1 * MiB;
constexpr size_t WS_MOD = 1 * MiB;
constexpr size_t WS_RCONST = 1 * MiB + 128 * 1024;
constexpr size_t WS_A2 = 1 * MiB + 192 * 1024;
constexpr size_t WS_WR = 1 * MiB + 256 * 1024;
constexpr size_t WS_SSQ = 2 * MiB;
constexpr size_t WS_SLOTTOK = 4 * MiB;
constexpr size_t WS_SLOTW = 5 * MiB;
constexpr size_t WS_ML = 6 * MiB;
constexpr size_t WS_LISTS = 10 * MiB;
constexpr size_t WS_WINT = 20 * MiB;
constexpr size_t WS_WOSGT = 56 * MiB;
constexpr size_t WS_WOATTT = 60 * MiB;
constexpr size_t WS_WOT = 64 * MiB;
constexpr size_t WS_H = 72 * MiB;
constexpr size_t WS_U = 136 * MiB;
constexpr size_t WS_VG = 168 * MiB;
constexpr size_t WS_Q = 200 * MiB;
constexpr size_t WS_K = 232 * MiB;
constexpr size_t WS_V = 264 * MiB;
constexpr size_t WS_GS = 296 * MiB;
constexpr size_t WS_GA = 360 * MiB;
constexpr size_t WS_YSG = 424 * MiB;
constexpr size_t WS_YATT = 456 * MiB;
constexpr size_t WS_END = 488 * MiB;
constexpr size_t WS_OPART = 72 * MiB;
constexpr size_t WS_MERGED = 200 * MiB;
constexpr size_t WS_TMP = 72 * MiB;
constexpr size_t WS_H2 = 72 * MiB;
constexpr size_t WS_W13T = 136 * MiB;
constexpr size_t WS_W2T = 264 * MiB;
constexpr size_t WS_ACT = 296 * MiB;
constexpr size_t WS_O0 = 332 * MiB;
constexpr size_t WS_O1 = 396 * MiB;
constexpr int LIST_PER_BH = 135168;
constexpr int CW_TMO = 0;
constexpr int CW_BAR = 4096;
constexpr int CW_ACNT = 8192;
constexpr int CW_ECNT = 9216;
constexpr int CW_KSUM = 16384;

constexpr int LDS_BYTES = 147456;
constexpr int RING_BYTES = 131072;
constexpr int TAB_OFF = 143360;
constexpr int MISC_OFF = 146432;

#define LDS_WAIT() asm volatile("s_waitcnt lgkmcnt(0)" ::: "memory")
#define VM_WAIT() asm volatile("s_waitcnt vmcnt(0)" ::: "memory")
__device__ __forceinline__ unsigned cvt_pk_bf16(float lo, float hi) { unsigned r; asm volatile("v_cvt_pk_bf16_f32 %0, %1, %2" : "=v"(r) : "v"(lo), "v"(hi)); return r; }
__device__ __forceinline__ float bf_lo(unsigned w) { return __uint_as_float(w << 16); }
__device__ __forceinline__ float bf_hi(unsigned w) { return __uint_as_float(w & 0xffff0000u); }
__device__ __forceinline__ float wave_sum(float v) {
#pragma unroll
    for (int o = 1; o < 64; o <<= 1) v += __shfl_xor(v, o);
    return v;
}
__device__ __forceinline__ f32x2 gelu_pk(f32x2 v) {
    const f32x2 av = __builtin_elementwise_abs(v), d = av * 0.2316418882f + 1.0f;
    f32x2 t; t.x = __builtin_amdgcn_rcpf(d.x); t.y = __builtin_amdgcn_rcpf(d.y);
    f32x2 q = t * 0.5307027145f + (-0.7265760135f); q = q * t + 0.7107068705f; q = q * t + (-0.142248368f); q = q * t + 0.127414796f; q = q * t;
    const f32x2 s = (v * v) * (-0.72134752044f);
    f32x2 e; e.x = __builtin_amdgcn_exp2f(s.x); e.y = __builtin_amdgcn_exp2f(s.y);
    const f32x2 m = v * (q * e), r = v - m;
    f32x2 o; o.x = v.x < 0.f ? m.x : r.x; o.y = v.y < 0.f ? m.y : r.y; return o;
}
__device__ __forceinline__ int lane_id() { return (int)__builtin_amdgcn_mbcnt_hi(~0u, __builtin_amdgcn_mbcnt_lo(~0u, 0u)); }
__device__ __forceinline__ float sigmoid_f(float x) { return __builtin_amdgcn_rcpf(1.0f + __builtin_amdgcn_exp2f(-x * LOG2E)); }

#define XB_TMO      128
#define XB_XCNT(j)  (256  + 64 * (j))
#define XB_XSUB(j)  (1280 + 64 * (j))
#define XB_XGEN(j)  (2304 + 64 * (j))
#define XB_TOP      3328
#define XB_TOPGEN   3392
#define XCD_BAR_WORDS 3456
#define XB_SPIN_CAP (1u << 18)
__device__ __forceinline__ unsigned xb_ld(unsigned* p)              { return __hip_atomic_load(p, __ATOMIC_RELAXED, __HIP_MEMORY_SCOPE_AGENT); }
__device__ __forceinline__ unsigned xb_add(unsigned* p, unsigned v) { return __hip_atomic_fetch_add(p, v, __ATOMIC_RELAXED, __HIP_MEMORY_SCOPE_AGENT); }
__device__ __forceinline__ unsigned xb_xcc_id() { return (unsigned)__builtin_amdgcn_s_getreg((3 << 11) | 20) & 0xFu; }
#define XB_SPIN(cond, bar) do { unsigned _sp = 0; while (cond) { __builtin_amdgcn_s_sleep(1); \
    if ((++_sp & 255u) == 0u) { if (xb_ld(&(bar)[XB_TMO])) break; if (_sp > XB_SPIN_CAP) { atomicAdd(&(bar)[XB_TMO], 1u); break; } } } } while (0)
struct XcdBarrier { unsigned* bar; unsigned x; volatile LAS unsigned* st; int wid; };
__device__ __forceinline__ XcdBarrier xcd_barrier_post(unsigned* bar, volatile LAS unsigned* st, int wid) {
    XcdBarrier b; b.bar = bar; b.x = xb_xcc_id(); b.st = st; b.wid = wid;
    if (wid == 0 && lane_id() == 0) (void)xb_add(&bar[XB_XCNT(b.x)], 1u);
    return b;
}
__device__ __forceinline__ void xcd_barrier_complete(unsigned* bar, unsigned x, unsigned& nloc, unsigned& nx) {
    const unsigned G = gridDim.x * gridDim.y * gridDim.z;
    unsigned sum, cnt, mine, sp = 0u;
    for (;;) {
        sum = 0u; cnt = 0u; mine = 0u;
#pragma unroll
        for (unsigned j = 0; j < 16; ++j) { const unsigned c = xb_ld(&bar[XB_XCNT(j)]); sum += c; cnt += (c > 0u) ? 1u : 0u; mine = (j == x) ? c : mine; }
        if (sum == G) break;
        __builtin_amdgcn_s_sleep(1);
        if ((++sp & 255u) == 0u) { if (xb_ld(&bar[XB_TMO])) break; if (sp > XB_SPIN_CAP) { atomicAdd(&bar[XB_TMO], 1u); break; } }
    }
    nloc = mine > 0u ? mine : 1u; nx = cnt > 0u ? cnt : 1u;
}
__device__ __forceinline__ void xcd_barrier(const XcdBarrier& b) {
    asm volatile("s_waitcnt vmcnt(0)" ::: "memory");
    __syncthreads();
    if (b.wid == 0 && lane_id() == 0) {
        unsigned* bar = b.bar;
        __builtin_amdgcn_s_waitcnt(0);
        unsigned nloc = b.st[0], nx = b.st[1];
        if (nloc == 0u) { xcd_barrier_complete(bar, b.x, nloc, nx); b.st[0] = nloc; b.st[1] = nx; }
        const unsigned old = xb_add(&bar[XB_XSUB(b.x)], 1u);
        const unsigned gen = old / nloc;
        if (old + 1u == (gen + 1u) * nloc) {
            __builtin_amdgcn_fence(__ATOMIC_RELEASE, "agent");
            asm volatile("s_waitcnt vmcnt(0)" ::: "memory");
            const unsigned og = xb_add(&bar[XB_TOP], 1u);
            const unsigned tg = og / nx;
            if (og + 1u == (tg + 1u) * nx) xb_add(&bar[XB_TOPGEN], 1u);
            else XB_SPIN(xb_ld(&bar[XB_TOPGEN]) == tg, bar);
            __builtin_amdgcn_fence(__ATOMIC_ACQUIRE, "agent");
            xb_add(&bar[XB_XGEN(b.x)], 1u);
            asm volatile("s_waitcnt vmcnt(0)" ::: "memory");
        } else {
            XB_SPIN(xb_ld(&bar[XB_XGEN(b.x)]) == gen, bar);
            __builtin_amdgcn_fence(__ATOMIC_ACQUIRE, "agent");
            asm volatile("s_waitcnt vmcnt(0)" ::: "memory");
        }
    }
    __syncthreads();
}

namespace pg8 {
constexpr int BM = 256, BK = 64, HALF = 128, HTB = HALF * BK * 2, STAGE_BYTES = 8 * HTB;
__host__ __device__ __forceinline__ int lds_byte(int r, int c) { const int st = (r >> 4) * 2 + (c >> 5), rr = r & 15, cc = c & 31, ob = rr * 64 + cc * 2; return st * 1024 + (ob ^ (((ob >> 9) & 1) << 5)); }
__host__ __device__ __forceinline__ void stage_rc(int b, int& R, int& C) { const int st = b / 1024, sb = b % 1024, swz = sb ^ (((sb >> 9) & 1) << 5); R = (st >> 1) * 16 + swz / 64; C = (st & 1) * 32 + (swz % 64) / 2; }
__host__ __device__ __forceinline__ int perm32(int rho) { const int n = rho >> 4, i = rho & 15; return 8 * (i >> 2) + 4 * n + (i & 3); }

struct Unit { const char* A; const char* B; int pm, pn, kind, aux; };

template <int K, bool PERM, bool GATHER, class Sched, class Epi>
__device__ __forceinline__ void gemm_phase(LAS unsigned char* lds, const int wid, const Sched& S, const Epi& E) {
    const int lane = lane_id(), tid = wid * 64 + lane, wr = wid >> 2, wc = wid & 3, fr = lane & 15, fq = lane >> 4;
    constexpr int nt = K / BK;
    int Rr[2], Cc[2]; unsigned voffB[2];
#pragma unroll
    for (int i = 0; i < 2; ++i) { int R, C; stage_rc(tid * 16 + i * 8192, R, C); Rr[i] = R; Cc[i] = C; const int Rb = PERM ? ((R & ~31) + perm32(R & 31)) : R; voffB[i] = (unsigned)(Rb * K + C) * 2u; }
    constexpr size_t kstep = (size_t)(BK * 2);
    constexpr size_t hstep = (size_t)HALF * K * 2;
    const unsigned ldsw = (unsigned)wid * 1024u;
    const int aoff = lds_byte(wr * 64 + fr, fq * 8), boff = lds_byte(wc * 32 + fr, fq * 8);
#define PG8_SA(b, h) (((b) * 2 + (h)) * HTB)
#define PG8_SB(b, h) ((4 + (b) * 2 + (h)) * HTB)
#define PG8_STAGE_B(b, h, gbase) do { _Pragma("unroll") for (int _i = 0; _i < 2; ++_i) \
        __builtin_amdgcn_global_load_lds((const unsigned*)((const char*)(gbase) + (size_t)(h) * hstep + voffB[_i]), (LAS unsigned*)(lds + PG8_SB(b, h) + ldsw + _i * 8192), 16, 0, 0); } while (0)
#define PG8_STAGE_A(b, h, gbase, VO) do { _Pragma("unroll") for (int _i = 0; _i < 2; ++_i) \
        __builtin_amdgcn_global_load_lds((const unsigned*)((const char*)(gbase) + (VO)[h][_i]), (LAS unsigned*)(lds + PG8_SA(b, h) + ldsw + _i * 8192), 16, 0, 0); } while (0)
#define PG8_LDA(dst, b, h) do { _Pragma("unroll") for (int m = 0; m < 4; ++m) _Pragma("unroll") for (int k = 0; k < 2; ++k) dst[m][k] = *(const LAS bf16x8*)(lds + PG8_SA(b, h) + aoff + m * 2048 + k * 1024); } while (0)
#define PG8_LDB(dst, b, h) do { _Pragma("unroll") for (int n = 0; n < 2; ++n) _Pragma("unroll") for (int k = 0; k < 2; ++k) dst[n][k] = *(const LAS bf16x8*)(lds + PG8_SB(b, h) + boff + n * 2048 + k * 1024); } while (0)
#define PG8_MMA(ai, bj, At, Bt) do { __builtin_amdgcn_s_setprio(1); _Pragma("unroll") for (int m = 0; m < 4; ++m) _Pragma("unroll") for (int n = 0; n < 2; ++n) _Pragma("unroll") for (int k = 0; k < 2; ++k) \
        acc[ai][bj][m][n] = __builtin_amdgcn_mfma_f32_16x16x32_bf16(Bt[n][k], At[m][k], acc[ai][bj][m][n], 0, 0, 0); __builtin_amdgcn_s_setprio(0); } while (0)
#define PG8_WAIT_V(n) asm volatile("s_waitcnt vmcnt(" #n ")" ::: "memory")
#define PG8_WAIT_L(n) asm volatile("s_waitcnt lgkmcnt(" #n ")" ::: "memory")
#define PG8_BAR __builtin_amdgcn_s_barrier()
#define PG8_SCHED __builtin_amdgcn_sched_barrier(0)
#define PG8_SETVO(VO, U) do { _Pragma("unroll") for (int _h = 0; _h < 2; ++_h) _Pragma("unroll") for (int _i = 0; _i < 2; ++_i) { \
        if constexpr (GATHER) (VO)[_h][_i] = ((unsigned)S.row_of((U), _h * HALF + Rr[_i]) * (unsigned)K + (unsigned)Cc[_i]) * 2u; \
        else (VO)[_h][_i] = (unsigned)(((_h * HALF + Rr[_i]) * K + Cc[_i]) * 2); } } while (0)
    Unit cur, nxt; int ui = 0;
    if (!S.next(0, cur)) return;
    f32x4 acc[2][2][4][2];
#pragma unroll
    for (int a = 0; a < 2; ++a)
#pragma unroll
        for (int b = 0; b < 2; ++b)
#pragma unroll
            for (int m = 0; m < 4; ++m)
#pragma unroll
                for (int n = 0; n < 2; ++n) acc[a][b][m][n] = (f32x4){0.f, 0.f, 0.f, 0.f};
    bf16x8 At[4][2], B0[2][2], B1[2][2];
    unsigned voC[2][2], voN[2][2];
    PG8_SETVO(voC, cur);
    const char* cA = cur.A; const char* cB = cur.B;
    PG8_STAGE_B(0, 0, cB); PG8_STAGE_B(0, 1, cB); PG8_STAGE_A(0, 0, cA, voC); PG8_STAGE_A(0, 1, cA, voC);
    if (wr == 1) PG8_BAR;
    PG8_WAIT_V(2); PG8_BAR;
    PG8_STAGE_B(1, 0, cB + kstep); PG8_STAGE_A(1, 0, cA + kstep, voC); PG8_STAGE_B(1, 1, cB + kstep);
    PG8_WAIT_V(6); PG8_BAR;
    for (;;) {
        const bool has_next = S.next(ui + 1, nxt);
        const char* nA = has_next ? nxt.A : cA; const char* nB = has_next ? nxt.B : cB;
        if constexpr (GATHER) { if (has_next) { PG8_SETVO(voN, nxt); } else {
#pragma unroll
            for (int _h = 0; _h < 2; ++_h)
#pragma unroll
                for (int _i = 0; _i < 2; ++_i) voN[_h][_i] = voC[_h][_i]; } }
        for (int t = 0; t < nt; t += 2) {
            const bool last = (t == nt - 2);
            const char* a1 = cA + (size_t)(t + 1) * kstep;
            const char* a2 = last ? nA : cA + (size_t)(t + 2) * kstep; const char* b2 = last ? nB : cB + (size_t)(t + 2) * kstep;
            const char* a3 = a2 + kstep; const char* b3 = b2 + kstep;
            unsigned vo2[2][2];
#pragma unroll
            for (int _h = 0; _h < 2; ++_h)
#pragma unroll
                for (int _i = 0; _i < 2; ++_i) { if constexpr (GATHER) vo2[_h][_i] = last ? voN[_h][_i] : voC[_h][_i]; else vo2[_h][_i] = voC[_h][_i]; }
            PG8_LDB(B0, 0, 0); PG8_LDB(B1, 0, 1); PG8_SCHED; PG8_LDA(At, 0, 0); PG8_STAGE_A(1, 1, a1, voC);
            PG8_WAIT_V(8); PG8_WAIT_L(0); PG8_BAR; PG8_MMA(0, 0, At, B0); PG8_MMA(0, 1, At, B1); PG8_BAR; PG8_SCHED;
            PG8_LDA(At, 0, 1); PG8_STAGE_B(0, 0, b2); PG8_STAGE_B(0, 1, b2); PG8_STAGE_A(0, 0, a2, vo2);
            PG8_WAIT_V(8); PG8_WAIT_L(0); PG8_BAR; PG8_MMA(1, 0, At, B0); PG8_MMA(1, 1, At, B1); PG8_BAR; PG8_SCHED;
            PG8_LDB(B0, 1, 0); PG8_LDB(B1, 1, 1); PG8_SCHED; PG8_LDA(At, 1, 0); PG8_STAGE_A(0, 1, a2, vo2);
            PG8_WAIT_V(8); PG8_WAIT_L(0); PG8_BAR; PG8_MMA(0, 0, At, B0); PG8_MMA(0, 1, At, B1); PG8_BAR; PG8_SCHED;
            PG8_LDA(At, 1, 1); PG8_STAGE_B(1, 0, b3); PG8_STAGE_B(1, 1, b3); PG8_STAGE_A(1, 0, a3, vo2);
            PG8_WAIT_V(8); PG8_WAIT_L(0); PG8_BAR; PG8_MMA(1, 0, At, B0); PG8_MMA(1, 1, At, B1); PG8_BAR; PG8_SCHED;
        }
        if (wr == 0) PG8_BAR;
        E(acc, cur, wr, wc, fr, fq);
        if (!has_next) break;
        if (!(Epi::CHAIN && cur.kind == 0)) {
#pragma unroll
        for (int a = 0; a < 2; ++a)
#pragma unroll
            for (int b = 0; b < 2; ++b)
#pragma unroll
                for (int m = 0; m < 4; ++m)
#pragma unroll
                    for (int n = 0; n < 2; ++n) acc[a][b][m][n] = (f32x4){0.f, 0.f, 0.f, 0.f};
        }
        cur = nxt; cA = nA; cB = nB; ++ui;
        if constexpr (GATHER) {
#pragma unroll
            for (int _h = 0; _h < 2; ++_h)
#pragma unroll
                for (int _i = 0; _i < 2; ++_i) voC[_h][_i] = voN[_h][_i]; }
        if (wr == 1) PG8_BAR;
    }
    PG8_WAIT_V(0);
    PG8_BAR;
#undef PG8_SA
#undef PG8_SB
#undef PG8_STAGE_A
#undef PG8_STAGE_B
#undef PG8_LDA
#undef PG8_LDB
#undef PG8_MMA
#undef PG8_WAIT_V
#undef PG8_WAIT_L
#undef PG8_BAR
#undef PG8_SCHED
#undef PG8_SETVO
}
}

struct Frame {
    LAS unsigned char* lds;
    volatile LAS unsigned* MISC;
    unsigned* ctl;
    unsigned char* ws;
    int tid, lane, wave, vcu, G;
    const float *x, *c, *w_ada, *b_ada, *norm1_w, *norm2_w, *final_w, *w_in, *sg_ln_w, *sg_ln_b, *w_spatial, *b_spatial, *rel_bias, *w_out_sg, *w_out_att, *w_o, *w_rg, *w_re, *w_eg, *w_eu, *w_ed;
    float* out;
};

struct TrItem { const float* W; bf16* WT; int ldw, ldt, k0, n0, out_row0; };
__device__ __forceinline__ void transpose_load(const TrItem& t, float (&tv)[32], int lane) {
#pragma unroll
    for (int i = 0; i < 32; ++i) { const int kk = 2 * i + (lane >> 5); tv[i] = t.W[(size_t)(t.k0 + kk) * t.ldw + t.n0 + (lane & 31)]; }
}
__device__ __forceinline__ void transpose_store(const TrItem& t, const float (&tv)[32], LAS float* scr, int lane) {
#pragma unroll
    for (int i = 0; i < 32; ++i) { const int kk = 2 * i + (lane >> 5); scr[kk * 33 + (lane & 31)] = tv[i]; }
    LDS_WAIT(); asm volatile("" ::: "memory");
    const int c = lane & 7;
#pragma unroll
    for (int j = 0; j < 4; ++j) { const int n = (lane >> 3) + 8 * j; const LAS float* s = scr + (8 * c) * 33 + n;
        u32x4 o; o.x = cvt_pk_bf16(s[0 * 33], s[1 * 33]); o.y = cvt_pk_bf16(s[2 * 33], s[3 * 33]); o.z = cvt_pk_bf16(s[4 * 33], s[5 * 33]); o.w = cvt_pk_bf16(s[6 * 33], s[7 * 33]);
        *(u32x4*)(t.WT + (size_t)(t.out_row0 + n) * t.ldt + t.k0 + 8 * c) = o; }
    LDS_WAIT(); asm volatile("" ::: "memory");
}
#define TRANSPOSE_LOOP(first, stride, n, ITEM) do { int it_ = (first); if (it_ < (n)) { TrItem cur_; ITEM(it_, cur_); float tva_[32]; transpose_load(cur_, tva_, F.lane); \
    for (;;) { const int nx_ = it_ + (stride); TrItem nxt_ = cur_; float tvb_[32]; const bool hn_ = nx_ < (n); if (hn_) { ITEM(nx_, nxt_); transpose_load(nxt_, tvb_, F.lane); } \
        transpose_store(cur_, tva_, scr, F.lane); if (!hn_) break; cur_ = nxt_; it_ = nx_; _Pragma("unroll") for (int q_ = 0; q_ < 32; ++q_) tva_[q_] = tvb_[q_]; } } } while (0)

__device__ __forceinline__ void p0_prologue(Frame& F) {
    LAS float* scr = (LAS float*)(F.lds + F.wave * 16384);
    const int gw = F.vcu * NWAVES + F.wave, NGW = F.G * NWAVES;
    bf16* WINT = (bf16*)(F.ws + WS_WINT); bf16* WOSGT = (bf16*)(F.ws + WS_WOSGT); bf16* WOATTT = (bf16*)(F.ws + WS_WOATTT); bf16* WOT = (bf16*)(F.ws + WS_WOT);
    constexpr int I_IN = (DM / 64) * (INCOLS / 32), I_SG = (DSG / 64) * (DM / 32), I_O = (DM / 64) * (DM / 32);
    constexpr int NITEMS = I_IN + 2 * I_SG + I_O;
#define P0_ITEM(it, T) do { int r = (it); \
        if (r < I_IN) { const int nb = INCOLS / 32; T = TrItem{F.w_in, WINT, INCOLS, DM, 64 * (r / nb), 32 * (r % nb), 32 * (r % nb)}; } \
        else if ((r -= I_IN) < I_SG) { const int nb = DM / 32; T = TrItem{F.w_out_sg, WOSGT, DM, DSG, 64 * (r / nb), 32 * (r % nb), 32 * (r % nb)}; } \
        else if ((r -= I_SG) < I_SG) { const int nb = DM / 32; T = TrItem{F.w_out_att, WOATTT, DM, DATT, 64 * (r / nb), 32 * (r % nb), 32 * (r % nb)}; } \
        else { r -= I_SG; const int nb = DM / 32; T = TrItem{F.w_o, WOT, DM, DM, 64 * (r / nb), 32 * (r % nb), 32 * (r % nb)}; } } while (0)
    TRANSPOSE_LOOP(gw, NGW, NITEMS, P0_ITEM);
#undef P0_ITEM
    __syncthreads();
    {
        float* mod = (float*)(F.ws + WS_MOD);
        LAS float* red = (LAS float*)F.lds;
        for (int cb = F.vcu; cb < (6 * DM) / 48; cb += F.G) {
            const int kq = F.tid / 12, cq = F.tid % 12;
            f32x4 a0 = {0.f, 0.f, 0.f, 0.f}, a1 = {0.f, 0.f, 0.f, 0.f};
            if (F.tid < 504) {
#pragma unroll 7
                for (int k = kq; k < DM; k += 42) {
                    const f32x4 w = *(const f32x4*)(F.w_ada + (size_t)k * (6 * DM) + cb * 48 + cq * 4);
                    const float c0 = F.c[k], c1 = F.c[DM + k];
                    const float s0 = c0 * sigmoid_f(c0), s1 = c1 * sigmoid_f(c1);
                    a0 += w * s0; a1 += w * s1;
                }
                *(LAS f32x4*)(red + (kq * 12 + cq) * 8) = a0; *(LAS f32x4*)(red + (kq * 12 + cq) * 8 + 4) = a1;
            }
            __syncthreads();
            if (F.tid < 96) {
                const int b = F.tid / 48, col = F.tid % 48, cq2 = col / 4, e = col % 4;
                float s = 0.f;
                for (int q = 0; q < 42; ++q) s += red[(q * 12 + cq2) * 8 + b * 4 + e];
                mod[b * (6 * DM) + cb * 48 + col] = s + F.b_ada[cb * 48 + col];
            }
            __syncthreads();
        }
    }
}

__device__ __forceinline__ void p1_norm1(Frame& F) {
    const int gw = F.vcu * NWAVES + F.wave, NGW = F.G * NWAVES;
    const float* mod = (const float*)(F.ws + WS_MOD);
    bf16* H = (bf16*)(F.ws + WS_H);
    int curb = -1; f32x4 av[8], sv[8];
    for (int m = gw; m < MTOK; m += 2 * NGW) {
        const int b = m / SEQ;
        if (b != curb) { curb = b;
#pragma unroll
            for (int j = 0; j < 8; ++j) { const int col = 4 * F.lane + 256 * j;
                const f32x4 w = *(const f32x4*)(F.norm1_w + col), sc = *(const f32x4*)(mod + b * (6 * DM) + DM + col);
                av[j] = w * (sc + 1.0f); sv[j] = *(const f32x4*)(mod + b * (6 * DM) + col); } }
        const f32x4* xr0 = (const f32x4*)(F.x + (size_t)m * DM) + F.lane; const f32x4* xr1 = (const f32x4*)(F.x + (size_t)(m + NGW) * DM) + F.lane;
        f32x4 v0[8], v1[8]; float s0 = 0.f, s1 = 0.f;
#pragma unroll
        for (int j = 0; j < 8; ++j) { v0[j] = xr0[64 * j]; v1[j] = xr1[64 * j]; }
#pragma unroll
        for (int j = 0; j < 8; ++j) { s0 += (v0[j].x * v0[j].x + v0[j].y * v0[j].y) + (v0[j].z * v0[j].z + v0[j].w * v0[j].w); s1 += (v1[j].x * v1[j].x + v1[j].y * v1[j].y) + (v1[j].z * v1[j].z + v1[j].w * v1[j].w); }
        const float r0 = 1.0f / sqrtf(wave_sum(s0) * (1.0f / DM) + EPS), r1 = 1.0f / sqrtf(wave_sum(s1) * (1.0f / DM) + EPS);
        u32x2* o0 = (u32x2*)(H + (size_t)m * DM) + F.lane; u32x2* o1 = (u32x2*)(H + (size_t)(m + NGW) * DM) + F.lane;
#pragma unroll
        for (int j = 0; j < 8; ++j) { const f32x4 h0 = v0[j] * r0 * av[j] + sv[j], h1 = v1[j] * r1 * av[j] + sv[j];
            u32x2 w0, w1; w0.x = cvt_pk_bf16(h0.x, h0.y); w0.y = cvt_pk_bf16(h0.z, h0.w); w1.x = cvt_pk_bf16(h1.x, h1.y); w1.y = cvt_pk_bf16(h1.z, h1.w); o0[64 * j] = w0; o1[64 * j] = w1; }
    }
    float* A2 = (float*)(F.ws + WS_A2); bf16* WR = (bf16*)(F.ws + WS_WR); float* RC = (float*)(F.ws + WS_RCONST);
    for (int idx = F.vcu * NTHR + F.tid; idx < BATCH * 32 * DM; idx += F.G * NTHR) {
        const int k = idx % DM, col = (idx / DM) % 32, b = idx / (32 * DM);
        const float a2 = F.norm2_w[k] * (1.0f + mod[b * (6 * DM) + 4 * DM + k]);
        if (col == 0) A2[b * DM + k] = a2;
        const float w = col < 4 ? F.w_rg[k * 4 + col] : (col < 20 ? F.w_re[k * 16 + (col - 4)] : 0.f);
        const float v = a2 * w;
        const unsigned hi = cvt_pk_bf16(v, 0.f) & 0xffffu; const float lo = v - bf_lo(hi);
        WR[((size_t)(b * 2 + 0) * 32 + col) * DM + k] = (bf16)hi;
        WR[((size_t)(b * 2 + 1) * 32 + col) * DM + k] = (bf16)(cvt_pk_bf16(lo, 0.f) & 0xffffu);
    }
    for (int it = gw; it < BATCH * 32; it += NGW) {
        const int b = it / 32, col = it % 32; float s = 0.f;
        for (int k = F.lane; k < DM; k += 64) { const float w = col < 4 ? F.w_rg[k * 4 + col] : (col < 20 ? F.w_re[k * 16 + (col - 4)] : 0.f); s += mod[b * (6 * DM) + 3 * DM + k] * w; }
        s = wave_sum(s);
        if (F.lane == 0) RC[b * 32 + col] = s;
    }
}

struct SchedGrid {
    const char* A; const char* B; int nN, nwg, G, c; size_t a_tstep, b_tstep;
    __device__ __forceinline__ bool next(int i, pg8::Unit& u) const {
        const int L = i * G + c; if (L >= nwg) return false;
        const int nig = 8 * nN, gid = L / nig, rem = L % nig;
        u.pm = gid * 8 + (rem & 7); u.pn = rem >> 3; u.kind = 0; u.aux = 0;
        u.A = A + (size_t)u.pm * a_tstep; u.B = B + (size_t)u.pn * b_tstep; return true;
    }
    __device__ __forceinline__ int row_of(const pg8::Unit&, int) const { return 0; }
};

struct EpiProj {
    static constexpr bool CHAIN = false;
    unsigned char* ws; float* ksum;
    __device__ __forceinline__ void operator()(f32x4 (&acc)[2][2][4][2], const pg8::Unit& u, int wr, int wc, int fr, int fq) const {
        const int pn = u.pn; int act, ld, colt; bf16* base;
        if (pn < 20) { const int t = pn >> 2; base = (bf16*)(ws + WS_U + (size_t)t * (32 * MiB)); ld = 1024; colt = (pn & 3) * 256; act = (t < 2) ? 1 : 0; }
        else { const int t = (pn - 20) >> 3; base = (bf16*)(ws + WS_GS + (size_t)t * (64 * MiB)); ld = 2048; colt = ((pn - 20) & 7) * 256; act = 2; }
        const int row0 = u.pm * 256 + wr * 64 + fr, col0 = colt + wc * 32 + 8 * fq;
        if (pn >= 12 && pn < 16) {
            const int b = u.pm >> 5, blk = u.pm & 31;
#pragma unroll
            for (int bj = 0; bj < 2; ++bj)
#pragma unroll
                for (int n = 0; n < 2; ++n) {
                    f32x4 s = {0.f, 0.f, 0.f, 0.f};
#pragma unroll
                    for (int ai = 0; ai < 2; ++ai)
#pragma unroll
                        for (int m = 0; m < 4; ++m) s += acc[ai][bj][m][n];
#pragma unroll
                    for (int o = 1; o < 16; o <<= 1) { s.x += __shfl_xor(s.x, o); s.y += __shfl_xor(s.y, o); s.z += __shfl_xor(s.z, o); s.w += __shfl_xor(s.w, o); }
                    if (fr == 0) { float* dst = ksum + (((b * 8 + (pn - 12) * 2 + bj) * 32 + blk) * 128 + wc * 32 + 8 * fq + 4 * n);
                        atomicAdd(dst + 0, s.x); atomicAdd(dst + 1, s.y); atomicAdd(dst + 2, s.z); atomicAdd(dst + 3, s.w); }
                }
        }
#pragma unroll
        for (int ai = 0; ai < 2; ++ai)
#pragma unroll
            for (int m = 0; m < 4; ++m) { bf16* rowp = base + (size_t)(row0 + ai * 128 + m * 16) * ld + col0;
#pragma unroll
                for (int bj = 0; bj < 2; ++bj) { f32x4 v0 = acc[ai][bj][m][0], v1 = acc[ai][bj][m][1];
                    if (act == 1) { const f32x2 a = gelu_pk((f32x2){v0[0], v0[1]}), b = gelu_pk((f32x2){v0[2], v0[3]}), c = gelu_pk((f32x2){v1[0], v1[1]}), d = gelu_pk((f32x2){v1[2], v1[3]});
                        v0 = (f32x4){a.x, a.y, b.x, b.y}; v1 = (f32x4){c.x, c.y, d.x, d.y}; }
                    else if (act == 2) {
#pragma unroll
                        for (int j = 0; j < 4; ++j) { v0[j] = sigmoid_f(v0[j]); v1[j] = sigmoid_f(v1[j]); } }
                    u32x4 w; w.x = cvt_pk_bf16(v0[0], v0[1]); w.y = cvt_pk_bf16(v0[2], v0[3]); w.z = cvt_pk_bf16(v1[0], v1[1]); w.w = cvt_pk_bf16(v1[2], v1[3]);
                    *(u32x4*)(rowp + bj * 128) = w; } }
    }
};

struct SchedPair {
    const char *A0, *A1, *B0, *B1; int G, c;
    __device__ __forceinline__ bool next(int i, pg8::Unit& u) const {
        const int L = (i >> 1) * G + c; if (L >= 512) return false;
        const int part = i & 1, gid = L >> 6, rem = L & 63;
        u.pm = gid * 8 + (rem & 7); u.pn = rem >> 3; u.kind = part; u.aux = 0;
        u.A = (part ? A1 : A0) + (size_t)u.pm * (256 * 1024 * 2); u.B = (part ? B1 : B0) + (size_t)u.pn * (256 * 1024 * 2); return true;
    }
    __device__ __forceinline__ int row_of(const pg8::Unit&, int) const { return 0; }
};
struct EpiMerge {
    static constexpr bool CHAIN = true;
    const bf16 *GS, *GA; bf16* MERGED;
    __device__ __forceinline__ void operator()(f32x4 (&acc)[2][2][4][2], const pg8::Unit& u, int wr, int wc, int fr, int fq) const {
        const int row0 = u.pm * 256 + wr * 64 + fr, col0 = u.pn * 256 + wc * 32 + 8 * fq;
        if (u.kind == 0) {
#pragma unroll
            for (int ai = 0; ai < 2; ++ai)
#pragma unroll
                for (int mp = 0; mp < 2; ++mp) { u32x4 ga[2][2], gs[2][2];
#pragma unroll
                    for (int mm = 0; mm < 2; ++mm)
#pragma unroll
                        for (int bj = 0; bj < 2; ++bj) { const size_t off = (size_t)(row0 + ai * 128 + (mp * 2 + mm) * 16) * DM + col0 + bj * 128; ga[mm][bj] = *(const u32x4*)(GA + off); gs[mm][bj] = *(const u32x4*)(GS + off); }
#pragma unroll
                    for (int mm = 0; mm < 2; ++mm)
#pragma unroll
                        for (int bj = 0; bj < 2; ++bj) { const int m = mp * 2 + mm; const u32x4 a = ga[mm][bj], g = gs[mm][bj];
                            const f32x4 a0 = {bf_lo(a.x), bf_hi(a.x), bf_lo(a.y), bf_hi(a.y)}, a1 = {bf_lo(a.z), bf_hi(a.z), bf_lo(a.w), bf_hi(a.w)};
                            const f32x4 s0 = {bf_lo(g.x), bf_hi(g.x), bf_lo(g.y), bf_hi(g.y)}, s1 = {bf_lo(g.z), bf_hi(g.z), bf_lo(g.w), bf_hi(g.w)};
#pragma unroll
                            for (int j = 0; j < 4; ++j) { acc[ai][bj][m][0][j] *= s0[j] * __builtin_amdgcn_rcpf(a0[j]); acc[ai][bj][m][1][j] *= s1[j] * __builtin_amdgcn_rcpf(a1[j]); } }
                    asm volatile("" ::: "memory"); }
        } else {
#pragma unroll
            for (int ai = 0; ai < 2; ++ai) { u32x4 ga[4][2];
#pragma unroll
                for (int m = 0; m < 4; ++m)
#pragma unroll
                    for (int bj = 0; bj < 2; ++bj) ga[m][bj] = *(const u32x4*)(GA + (size_t)(row0 + ai * 128 + m * 16) * DM + col0 + bj * 128);
#pragma unroll
                for (int m = 0; m < 4; ++m)
#pragma unroll
                    for (int bj = 0; bj < 2; ++bj) { const u32x4 a = ga[m][bj];
                        const f32x4 a0 = {bf_lo(a.x), bf_hi(a.x), bf_lo(a.y), bf_hi(a.y)}, a1 = {bf_lo(a.z), bf_hi(a.z), bf_lo(a.w), bf_hi(a.w)};
                        const f32x4 v0 = acc[ai][bj][m][0] * a0, v1 = acc[ai][bj][m][1] * a1;
                        u32x4 w; w.x = cvt_pk_bf16(v0[0], v0[1]); w.y = cvt_pk_bf16(v0[2], v0[3]); w.z = cvt_pk_bf16(v1[0], v1[1]); w.w = cvt_pk_bf16(v1[2], v1[3]);
                        *(u32x4*)(MERGED + (size_t)(row0 + ai * 128 + m * 16) * DM + col0 + bj * 128) = w; }
                asm volatile("" ::: "memory"); }
        }
    }
};

struct EpiX1 {
    static constexpr bool CHAIN = false;
    const float* x; const float* mod; float* out; float* ssq;
    __device__ __forceinline__ void operator()(f32x4 (&acc)[2][2][4][2], const pg8::Unit& u, int wr, int wc, int fr, int fq) const {
        const int row0 = u.pm * 256 + wr * 64 + fr, col0 = u.pn * 256 + wc * 32 + 4 * fq;
        const float* g1 = mod + (u.pm >> 5) * (6 * DM) + 2 * DM + col0;
        f32x4 gv[2][2];
#pragma unroll
        for (int bj = 0; bj < 2; ++bj)
#pragma unroll
            for (int n = 0; n < 2; ++n) gv[bj][n] = *(const f32x4*)(g1 + bj * 128 + n * 16);
#pragma unroll
        for (int ai = 0; ai < 2; ++ai)
#pragma unroll
          for (int mp = 0; mp < 2; ++mp) { f32x4 xv[2][2][2];
#pragma unroll
            for (int mm = 0; mm < 2; ++mm)
#pragma unroll
                for (int bj = 0; bj < 2; ++bj)
#pragma unroll
                    for (int n = 0; n < 2; ++n) xv[mm][bj][n] = *(const f32x4*)(x + (size_t)(row0 + ai * 128 + (mp * 2 + mm) * 16) * DM + col0 + bj * 128 + n * 16);
#pragma unroll
            for (int mm = 0; mm < 2; ++mm) { const int m = mp * 2 + mm; const int row = row0 + ai * 128 + m * 16; const size_t off = (size_t)row * DM + col0; float s = 0.f;
#pragma unroll
                for (int bj = 0; bj < 2; ++bj)
#pragma unroll
                    for (int n = 0; n < 2; ++n) { const f32x4 o = xv[mm][bj][n] + gv[bj][n] * acc[ai][bj][m][n];
                        *(f32x4*)(out + off + bj * 128 + n * 16) = o; s += (o.x * o.x + o.y * o.y) + (o.z * o.z + o.w * o.w); }
                s += __shfl_xor(s, 16); s += __shfl_xor(s, 32);
                if (fq == 0) ssq[(size_t)row * 32 + u.pn * 4 + wc] = s; }
            asm volatile("" ::: "memory"); }
    }
};

struct SchedMoe {
    const unsigned* slottok; const char* A; const char* B; const LAS int* tab; int G, c, shift; size_t b_estep, b_tstep, a_tstep;
    __device__ __forceinline__ bool next(int i, pg8::Unit& u) const {
        const int L = i * G + c; if (L >= (tab[16] << shift)) return false;
        const int tile = L >> shift; u.pn = L & ((1 << shift) - 1); int e = 0; while (tab[e + 1] <= tile) ++e;
        u.pm = tile; u.kind = e; u.aux = tile - tab[e];
        u.A = A + (size_t)tile * a_tstep; u.B = B + (size_t)e * b_estep + (size_t)u.pn * b_tstep; return true;
    }
    __device__ __forceinline__ int row_of(const pg8::Unit& u, int r) const { const int sl = u.aux * 256 + r; return sl < tab[32 + u.kind] ? (int)(slottok[u.kind * 16384 + sl] & 0xffffu) : 0; }
};
struct EpiSwiglu {
    static constexpr bool CHAIN = false;
    bf16* ACT;
    __device__ __forceinline__ void operator()(f32x4 (&acc)[2][2][4][2], const pg8::Unit& u, int wr, int wc, int fr, int fq) const {
        const int row0 = u.pm * 256 + wr * 64 + fr, col0 = u.pn * 128 + wc * 32 + 8 * fq;
#pragma unroll
        for (int ai = 0; ai < 2; ++ai)
#pragma unroll
            for (int m = 0; m < 4; ++m) { f32x4 v0, v1;
#pragma unroll
                for (int j = 0; j < 4; ++j) { const float g0 = acc[ai][0][m][0][j], g1 = acc[ai][0][m][1][j];
                    v0[j] = g0 * sigmoid_f(g0) * acc[ai][1][m][0][j]; v1[j] = g1 * sigmoid_f(g1) * acc[ai][1][m][1][j]; }
                u32x4 w; w.x = cvt_pk_bf16(v0[0], v0[1]); w.y = cvt_pk_bf16(v0[2], v0[3]); w.z = cvt_pk_bf16(v1[0], v1[1]); w.w = cvt_pk_bf16(v1[2], v1[3]);
                *(u32x4*)(ACT + (size_t)(row0 + ai * 128 + m * 16) * DE + col0) = w; }
    }
};
struct EpiDown {
    static constexpr bool CHAIN = false;
    const unsigned* slottok; const float* slotw; const LAS int* tab; bf16 *O0, *O1;
    __device__ __forceinline__ void operator()(f32x4 (&acc)[2][2][4][2], const pg8::Unit& u, int wr, int wc, int fr, int fq) const {
        const int e = u.kind, cnt = tab[32 + e], col0 = u.pn * 256 + wc * 32 + 8 * fq;
        unsigned info[2][4]; float wt[2][4];
#pragma unroll
        for (int ai = 0; ai < 2; ++ai)
#pragma unroll
            for (int m = 0; m < 4; ++m) { const int sl = u.aux * 256 + ai * 128 + wr * 64 + m * 16 + fr; const bool ok = sl < cnt;
                info[ai][m] = ok ? slottok[e * 16384 + sl] : 0xffffffffu; wt[ai][m] = ok ? slotw[e * 16384 + sl] : 0.f; }
#pragma unroll
        for (int ai = 0; ai < 2; ++ai)
#pragma unroll
            for (int m = 0; m < 4; ++m) {
                if (info[ai][m] != 0xffffffffu) { const float w = wt[ai][m];
                    bf16* dst = ((info[ai][m] >> 16) ? O1 : O0) + (size_t)(info[ai][m] & 0xffffu) * DM + col0;
#pragma unroll
                    for (int bj = 0; bj < 2; ++bj) { const f32x4 v0 = acc[ai][bj][m][0] * w, v1 = acc[ai][bj][m][1] * w;
                        u32x4 o; o.x = cvt_pk_bf16(v0[0], v0[1]); o.y = cvt_pk_bf16(v0[2], v0[3]); o.z = cvt_pk_bf16(v1[0], v1[1]); o.w = cvt_pk_bf16(v1[2], v1[3]);
                        *(u32x4*)(dst + bj * 128) = o; } } }
    }
};

__device__ __forceinline__ int list_base(int b, int h, int j) { return (b * 8 + h) * LIST_PER_BH + 256 * (32 * j - (j * (j - 1)) / 2); }

__device__ __forceinline__ void sgu_unit(Frame& F, int b, int c, int half) {
    LAS float* st = (LAS float*)F.lds;
    LAS bf16* vnT = (LAS bf16*)(F.lds + 1024);
    const int r0 = b * SEQ + c * 128;
    const bf16* VG = (const bf16*)(F.ws + WS_VG); const bf16* U = (const bf16*)(F.ws + WS_U); bf16* YSG = (bf16*)(F.ws + WS_YSG);
    { u32x4 ra[16], rq[16];
#pragma unroll
      for (int rr = 0; rr < 16; ++rr) { const u32x4* p = (const u32x4*)(VG + (size_t)(r0 + F.wave * 16 + rr) * DSG) + F.lane * 2; ra[rr] = p[0]; rq[rr] = p[1]; }
#pragma unroll
      for (int rr = 0; rr < 16; ++rr) { const int row = F.wave * 16 + rr; float s = 0.f, ss = 0.f;
        const unsigned wv[8] = {ra[rr].x, ra[rr].y, ra[rr].z, ra[rr].w, rq[rr].x, rq[rr].y, rq[rr].z, rq[rr].w};
#pragma unroll
        for (int e = 0; e < 8; ++e) { const float lo = bf_lo(wv[e]), hi = bf_hi(wv[e]); s += lo + hi; ss += lo * lo + hi * hi; }
        s = wave_sum(s); ss = wave_sum(ss);
        const float mean = s * (1.0f / DSG), var = fmaxf(ss * (1.0f / DSG) - mean * mean, 0.f);
        if (F.lane == 0) { st[row * 2] = mean; st[row * 2 + 1] = 1.0f / sqrtf(var + EPS); } } }
    __syncthreads();
    for (int gi = 0; gi < 4; ++gi) { const int g = half * 4 + gi;
        { const int s = F.tid >> 2, dq = F.tid & 3; const float mean = st[s * 2], rstd = st[s * 2 + 1];
          const bf16* src = VG + (size_t)(r0 + s) * DSG + g * 128 + dq * 32;
#pragma unroll
          for (int v4 = 0; v4 < 4; ++v4) { const u32x4 w = *(const u32x4*)(src + v4 * 8); const unsigned wv[4] = {w.x, w.y, w.z, w.w};
              const int colb = g * 128 + dq * 32 + v4 * 8;
              const f32x4 lw0 = *(const f32x4*)(F.sg_ln_w + colb), lw1 = *(const f32x4*)(F.sg_ln_w + colb + 4), lb0 = *(const f32x4*)(F.sg_ln_b + colb), lb1 = *(const f32x4*)(F.sg_ln_b + colb + 4);
              const float lw[8] = {lw0.x, lw0.y, lw0.z, lw0.w, lw1.x, lw1.y, lw1.z, lw1.w}, lb[8] = {lb0.x, lb0.y, lb0.z, lb0.w, lb1.x, lb1.y, lb1.z, lb1.w};
#pragma unroll
              for (int e = 0; e < 4; ++e) { const float x0 = bf_lo(wv[e]), x1 = bf_hi(wv[e]);
                  const float n0 = (x0 - mean) * rstd * lw[2 * e] + lb[2 * e], n1 = (x1 - mean) * rstd * lw[2 * e + 1] + lb[2 * e + 1];
                  const unsigned pk = cvt_pk_bf16(n0, n1);
                  vnT[(dq * 32 + v4 * 8 + 2 * e) * 136 + s] = (bf16)(pk & 0xffffu); vnT[(dq * 32 + v4 * 8 + 2 * e + 1) * 136 + s] = (bf16)(pk >> 16); } } }
        __syncthreads();
        { const int t0 = F.wave * 16, cl = F.lane & 15, g4 = F.lane >> 4, t = t0 + cl, nks = (t0 + 15) / 32 + 1;
          bf16x8 wf[4];
#pragma unroll
          for (int ks = 0; ks < 4; ++ks) { u32x4 pk = {0u, 0u, 0u, 0u};
              if (ks < nks) { const int s0 = ks * 32 + 8 * g4; const float* wp = F.w_spatial + ((size_t)(g * 128 + t)) * 128 + s0;
                  const f32x4 w0 = *(const f32x4*)wp, w1 = *(const f32x4*)(wp + 4);
                  float wv[8] = {w0.x, w0.y, w0.z, w0.w, w1.x, w1.y, w1.z, w1.w};
#pragma unroll
                  for (int jj = 0; jj < 8; ++jj) wv[jj] = (s0 + jj <= t) ? wv[jj] : 0.f;
                  pk.x = cvt_pk_bf16(wv[0], wv[1]); pk.y = cvt_pk_bf16(wv[2], wv[3]); pk.z = cvt_pk_bf16(wv[4], wv[5]); pk.w = cvt_pk_bf16(wv[6], wv[7]); }
              wf[ks] = __builtin_bit_cast(bf16x8, pk); }
          const float bias = F.b_spatial[g * 128 + t];
          u32x2 uu8[8];
#pragma unroll
          for (int db = 0; db < 8; ++db) uu8[db] = *(const u32x2*)(U + (size_t)(r0 + t) * DSG + g * 128 + db * 16 + 4 * g4);
#pragma unroll
          for (int db = 0; db < 8; ++db) { f32x4 acc = {0.f, 0.f, 0.f, 0.f};
#pragma unroll
              for (int ks = 0; ks < 4; ++ks) if (ks < nks) { const bf16x8 a = *(const LAS bf16x8*)(vnT + (db * 16 + cl) * 136 + ks * 32 + 8 * g4); acc = __builtin_amdgcn_mfma_f32_16x16x32_bf16(a, wf[ks], acc, 0, 0, 0); }
              const size_t off = (size_t)(r0 + t) * DSG + g * 128 + db * 16 + 4 * g4;
              const u32x2 uu = uu8[db];
              u32x2 o; o.x = cvt_pk_bf16(bf_lo(uu.x) * (acc[0] + bias), bf_hi(uu.x) * (acc[1] + bias)); o.y = cvt_pk_bf16(bf_lo(uu.y) * (acc[2] + bias), bf_hi(uu.y) * (acc[3] + bias));
              *(u32x2*)(YSG + off) = o; } }
        __syncthreads();
    }
}

__device__ __forceinline__ void select_unit(Frame& F, int b, int h, int i) {
    LAS float* ks = (LAS float*)F.lds;
    LAS int* lcnt = (LAS int*)(F.lds + 17408); LAS int* gbase = lcnt + 32;
    const float* ksum = (const float*)(F.ctl + CW_KSUM) + (size_t)(b * 8 + h) * 32 * 128;
    unsigned* acnt = F.ctl + CW_ACNT + (b * 8 + h) * 32;
    unsigned* lists = (unsigned*)(F.ws + WS_LISTS); f32x2* ML = (f32x2*)(F.ws + WS_ML);
    for (int idx = F.tid; idx < 32 * 128; idx += NTHR) { const int j = idx >> 7; ks[j * 132 + (idx & 127)] = j < i ? ksum[idx] : 0.f; }
    if (F.tid < 32) lcnt[F.tid] = 0;
    __syncthreads();
    const int r32 = F.lane & 31, hi = F.lane >> 5, q = F.wave * 32 + r32, s = i * 256 + q;
    const bf16* Qw = (const bf16*)(F.ws + WS_Q) + (size_t)(b * SEQ + s) * DATT + h * 128 + hi * 8;
    bf16x8 qr[8];
#pragma unroll
    for (int d0 = 0; d0 < 8; ++d0) qr[d0] = *(const bf16x8*)(Qw + d0 * 16);
    f32x16 p = {};
#pragma unroll
    for (int d0 = 0; d0 < 8; ++d0) { const LAS f32x4* kp = (const LAS f32x4*)(ks + r32 * 132 + d0 * 16 + hi * 8); const f32x4 k0 = kp[0], k1 = kp[1];
        u32x4 kh; kh.x = cvt_pk_bf16(k0.x, k0.y); kh.y = cvt_pk_bf16(k0.z, k0.w); kh.z = cvt_pk_bf16(k1.x, k1.y); kh.w = cvt_pk_bf16(k1.z, k1.w);
        u32x4 kl; kl.x = cvt_pk_bf16(k0.x - bf_lo(kh.x), k0.y - bf_hi(kh.x)); kl.y = cvt_pk_bf16(k0.z - bf_lo(kh.y), k0.w - bf_hi(kh.y));
        kl.z = cvt_pk_bf16(k1.x - bf_lo(kh.z), k1.y - bf_hi(kh.z)); kl.w = cvt_pk_bf16(k1.z - bf_lo(kh.w), k1.w - bf_hi(kh.w));
        p = __builtin_amdgcn_mfma_f32_32x32x16_bf16(__builtin_bit_cast(bf16x8, kh), qr[d0], p, 0, 0, 0);
        p = __builtin_amdgcn_mfma_f32_32x32x16_bf16(__builtin_bit_cast(bf16x8, kl), qr[d0], p, 0, 0, 0); }
    float s1 = -INFINITY, s2 = -INFINITY, s3 = -INFINITY; int j1 = 64, j2 = 65, j3 = 66;
#define SEL_INS(dv, jv) do { const float d_ = (dv); const int j_ = (jv); \
        if (d_ > s1 || (d_ == s1 && j_ < j1)) { s3 = s2; j3 = j2; s2 = s1; j2 = j1; s1 = d_; j1 = j_; } \
        else if (d_ > s2 || (d_ == s2 && j_ < j2)) { s3 = s2; j3 = j2; s2 = d_; j2 = j_; } \
        else if (d_ > s3 || (d_ == s3 && j_ < j3)) { s3 = d_; j3 = j_; } } while (0)
#pragma unroll
    for (int r = 0; r < 16; ++r) { const int j = (r & 3) + 8 * (r >> 2) + 4 * hi; if (j < i) SEL_INS(p[r], j); }
    { const float t1 = __shfl_xor(s1, 32), t2 = __shfl_xor(s2, 32), t3 = __shfl_xor(s3, 32); const int u1 = __shfl_xor(j1, 32), u2 = __shfl_xor(j2, 32), u3 = __shfl_xor(j3, 32);
      if (u1 < 32) SEL_INS(t1, u1); if (u2 < 32) SEL_INS(t2, u2); if (u3 < 32) SEL_INS(t3, u3); }
#undef SEL_INS
    const int nv = i < 3 ? i : 3;
    int pos0 = 0, pos1 = 0, pos2 = 0;
    if (hi == 0) { if (nv > 0) pos0 = atomicAdd((int*)&lcnt[j1], 1); if (nv > 1) pos1 = atomicAdd((int*)&lcnt[j2], 1); if (nv > 2) pos2 = atomicAdd((int*)&lcnt[j3], 1); }
    __syncthreads();
    if (F.tid < 32) { const int n = lcnt[F.tid]; gbase[F.tid] = n > 0 ? (int)atomicAdd(acnt + F.tid, (unsigned)n) : 0; }
    __syncthreads();
    if (hi == 0) {
        const size_t mlb = ((size_t)(b * 8 + h) * SEQ + s) * 4;
        if (nv > 0) lists[list_base(b, h, j1) + 256 + gbase[j1] + pos0] = ((unsigned)s << 2) | 0u; else ML[mlb + 0] = (f32x2){-1e30f, 0.f};
        if (nv > 1) lists[list_base(b, h, j2) + 256 + gbase[j2] + pos1] = ((unsigned)s << 2) | 1u; else ML[mlb + 1] = (f32x2){-1e30f, 0.f};
        if (nv > 2) lists[list_base(b, h, j3) + 256 + gbase[j3] + pos2] = ((unsigned)s << 2) | 2u; else ML[mlb + 2] = (f32x2){-1e30f, 0.f};
        lists[list_base(b, h, i) + q] = ((unsigned)s << 2) | 3u;
    }
    __syncthreads();
}

namespace att {
constexpr int KVBLK = 64;
constexpr int SHM_V = KVBLK * HD * 2, SHM_K = KVBLK * HD * 2;
constexpr int WS_OFF = 65536, LUT_OFF = 67584, PRE_OFF = 69888, OST_OFF = 72192, OST_WAVE = 8704, OST_STRIDE = 272;
constexpr float SCALE = 0.088388347648318440f;
constexpr float C = SCALE * LOG2E;
constexpr float THR2 = 11.5f;
#define KSWZ(row, colB) ((row) * 256 + ((colB) ^ (((row) & 7) << 4)))
#define SBAR() __builtin_amdgcn_sched_barrier(0)
__device__ __forceinline__ int crow(int r, int hi) { return (r & 3) + 8 * (r >> 2) + 4 * hi; }
__device__ __forceinline__ void partialSM(f32x16& p0, f32x16& p1, float& m_reg, float& mn, float& alpha, int relb, int hi, const LAS float* lut) {
    if (__all(relb - 63 >= 128)) { const float c31 = lut[512];
#pragma unroll
        for (int r = 0; r < 16; ++r) { p0[r] = fmaf(p0[r], C, c31); p1[r] = fmaf(p1[r], C, c31); } }
    else {
#pragma unroll
        for (int r = 0; r < 16; ++r) { const int rel = relb - crow(r, hi);
            const int i0 = min(max(rel + 1, 0), 512), i1 = min(max(rel - 31, 0), 512);
            p0[r] = fmaf(p0[r], C, lut[i0]); p1[r] = fmaf(p1[r], C, lut[i1]); } }
    float pmax = p0[0];
#pragma unroll
    for (int r = 1; r < 16; ++r) pmax = fmaxf(pmax, p0[r]);
#pragma unroll
    for (int r = 0; r < 16; ++r) pmax = fmaxf(pmax, p1[r]);
    { auto rr = __builtin_amdgcn_permlane32_swap(__float_as_uint(pmax), __float_as_uint(pmax), false, false);
      pmax = fmaxf(__uint_as_float(rr[0]), __uint_as_float(rr[1])); }
    if (__builtin_expect(__all(pmax - m_reg <= THR2), 1)) { mn = m_reg; alpha = 1.f; }
    else { mn = fmaxf(m_reg, pmax); alpha = __builtin_amdgcn_exp2f(m_reg - mn); m_reg = mn; }
#pragma unroll
    for (int r = 0; r < 16; ++r) { p0[r] -= mn; p1[r] -= mn; }
#pragma unroll
    for (int r = 0; r < 16; ++r) p0[r] = __builtin_amdgcn_exp2f(p0[r]);
}
__device__ __forceinline__ void finishSM(f32x16& p0, f32x16& p1, float alpha, float& l_reg, bf16x8& pa0, bf16x8& pa1, bf16x8& pa2, bf16x8& pa3) {
#pragma unroll
    for (int r = 0; r < 16; ++r) p1[r] = __builtin_amdgcn_exp2f(p1[r]);
    float ps = 0;
#pragma unroll
    for (int r = 0; r < 16; ++r) ps += p0[r];
#pragma unroll
    for (int r = 0; r < 16; ++r) ps += p1[r];
    { auto rr = __builtin_amdgcn_permlane32_swap(__float_as_uint(ps), __float_as_uint(ps), false, false);
      ps = __uint_as_float(rr[0]) + __uint_as_float(rr[1]); }
    l_reg = l_reg * alpha + ps;
#define PK4(P, BASE, OUT) do { unsigned a0 = cvt_pk_bf16(P[BASE + 0], P[BASE + 1]), a1 = cvt_pk_bf16(P[BASE + 2], P[BASE + 3]);   \
    unsigned b0 = cvt_pk_bf16(P[BASE + 4], P[BASE + 5]), b1 = cvt_pk_bf16(P[BASE + 6], P[BASE + 7]);                              \
    auto r0 = __builtin_amdgcn_permlane32_swap(a0, b0, false, false); auto r1 = __builtin_amdgcn_permlane32_swap(a1, b1, false, false); \
    u32x4 w = {r0[0], r1[0], r0[1], r1[1]}; OUT = __builtin_bit_cast(bf16x8, w); } while (0)
    PK4(p0, 0, pa0); PK4(p0, 8, pa1); PK4(p1, 0, pa2); PK4(p1, 8, pa3);
#undef PK4
}
__device__ __forceinline__ void qkt(f32x16& p0, f32x16& p1, const LAS char* Ks, const bf16x8* qr, int r32, int hi) {
    p0 = f32x16{}; p1 = f32x16{};
#pragma unroll
    for (int d0 = 0; d0 < 8; ++d0) { const int cb = (d0 * 16 + hi * 8) * 2;
        const bf16x8 b0 = *(const LAS bf16x8*)(Ks + KSWZ(r32, cb));
        const bf16x8 b1 = *(const LAS bf16x8*)(Ks + KSWZ(32 + r32, cb));
        p0 = __builtin_amdgcn_mfma_f32_32x32x16_bf16(b0, qr[d0], p0, 0, 0, 0);
        p1 = __builtin_amdgcn_mfma_f32_32x32x16_bf16(b1, qr[d0], p1, 0, 0, 0); }
}
__device__ __forceinline__ int v_st(int k, int c) { const int kk = (k & ~0xC) | ((k & 4) << 1) | ((k & 8) >> 1); return ((kk >> 3) * 4 + (c >> 5)) * 512 + ((kk & 7) * 32 + (c & 31)) * 2; }
__device__ __forceinline__ int v_rd_base(int lane) { return ((lane & 3) << 3) | (((lane >> 2) & 3) << 6) | (((lane >> 4) & 1) << 5) | (((lane >> 5) & 1) << 8); }
constexpr int v_rd_off(int d0, int ks, int half) { return d0 * 512 + ks * 4096 + half * 2048; }
template <int OFF> __device__ __forceinline__ s16x4 tr_read(int vb) {
    s16x4 r; asm volatile("ds_read_b64_tr_b16 %0, %1 offset:%2" : "=&v"(r) : "v"(vb), "i"(OFF) : "memory"); return r;
}
template <int D0> __device__ __forceinline__ void pv_one(f32x16& od, int vb, bf16x8 pa0, bf16x8 pa1, bf16x8 pa2, bf16x8 pa3) {
    const s16x4 l0 = tr_read<v_rd_off(D0, 0, 0)>(vb), h0 = tr_read<v_rd_off(D0, 0, 1)>(vb), l1 = tr_read<v_rd_off(D0, 1, 0)>(vb), h1 = tr_read<v_rd_off(D0, 1, 1)>(vb);
    const s16x4 l2 = tr_read<v_rd_off(D0, 2, 0)>(vb), h2 = tr_read<v_rd_off(D0, 2, 1)>(vb), l3 = tr_read<v_rd_off(D0, 3, 0)>(vb), h3 = tr_read<v_rd_off(D0, 3, 1)>(vb);
    asm volatile("s_waitcnt lgkmcnt(0)" ::: "memory"); SBAR();
#define PK(L, H) (bf16x8){L[0], L[1], L[2], L[3], H[0], H[1], H[2], H[3]}
    od = __builtin_amdgcn_mfma_f32_32x32x16_bf16(pa0, PK(l0, h0), od, 0, 0, 0);
    od = __builtin_amdgcn_mfma_f32_32x32x16_bf16(pa1, PK(l1, h1), od, 0, 0, 0);
    od = __builtin_amdgcn_mfma_f32_32x32x16_bf16(pa2, PK(l2, h2), od, 0, 0, 0);
    od = __builtin_amdgcn_mfma_f32_32x32x16_bf16(pa3, PK(l3, h3), od, 0, 0, 0);
#undef PK
}
__device__ __forceinline__ void pv_d0(f32x16* o, int vb, bf16x8 pa0, bf16x8 pa1, bf16x8 pa2, bf16x8 pa3) {
    pv_one<0>(o[0], vb, pa0, pa1, pa2, pa3); pv_one<1>(o[1], vb, pa0, pa1, pa2, pa3); pv_one<2>(o[2], vb, pa0, pa1, pa2, pa3); pv_one<3>(o[3], vb, pa0, pa1, pa2, pa3);
}

__device__ __forceinline__ void attn_tile(LAS char* lds, const int wid, const unsigned* list, int n, int ti, int b, int h, int j,
                                          const bf16* Qg, const bf16* Kg, const bf16* Vg, bf16* OP, f32x2* ML) {
    constexpr int LDK = DATT;
    int lane_ = lane_id(); asm volatile("" : "+v"(lane_));
    const int lane = lane_, tid = wid * 64 + lane, r32 = lane & 31, hi = lane >> 5;
    LAS char* V_lds = lds; LAS char* K_lds = lds + 2 * SHM_V;
    LAS float* wsf = (LAS float*)(lds + WS_OFF) + wid * 64; LAS float* li_l = wsf; LAS float* al_l = wsf + 32;
    const LAS float* lut = (const LAS float*)(lds + LUT_OFF);
    LAS char* ost = lds + OST_OFF + wid * OST_WAVE;
    const int pos = ti * 256 + wid * 32 + r32; const bool valid = pos < n;
    const unsigned entry = list[valid ? pos : n - 1];
    const int qpos = (int)(entry >> 2), pick = (int)(entry & 3u);
    const int relq = qpos - 256 * j;
    float m_reg = -1e30f, l_reg = 0; f32x16 o[4] = {}; bf16x8 qr[8];
    const bf16* Qw = Qg + (size_t)(b * SEQ + qpos) * DATT + h * HD + hi * 8;
#pragma unroll
    for (int d0 = 0; d0 < 8; ++d0) qr[d0] = *(const bf16x8*)(Qw + d0 * 16);
    const bf16* Kh = Kg + (size_t)(b * SEQ + 256 * j) * DATT + h * HD; const bf16* Vh = Vg + (size_t)(b * SEQ + 256 * j) * DATT + h * HD;
    const int sr = tid >> 4, sc = (tid & 15) * 8, vst0 = v_st(sr, sc), vst1 = v_st(32 + sr, sc);
    const int vb0 = (int)(uintptr_t)V_lds + v_rd_base(lane);
    struct { bf16x8 vs0, vs1, ks0, ks1; } sr_[2];
#define SLOAD(i, k0) do { sr_[i].vs0 = *(const bf16x8*)(&Vh[(size_t)((k0) + sr) * LDK + sc]); sr_[i].vs1 = *(const bf16x8*)(&Vh[(size_t)((k0) + 32 + sr) * LDK + sc]); \
    sr_[i].ks0 = *(const bf16x8*)(&Kh[(size_t)((k0) + sr) * LDK + sc]); sr_[i].ks1 = *(const bf16x8*)(&Kh[(size_t)((k0) + 32 + sr) * LDK + sc]); } while (0)
#define SWRITE(bb, i) do { *(LAS bf16x8*)(V_lds + (bb) * SHM_V + vst0) = sr_[i].vs0; *(LAS bf16x8*)(V_lds + (bb) * SHM_V + vst1) = sr_[i].vs1; const int kc = sc * 2; \
    *(LAS bf16x8*)(K_lds + (bb) * SHM_K + KSWZ(sr, kc)) = sr_[i].ks0; *(LAS bf16x8*)(K_lds + (bb) * SHM_K + KSWZ(32 + sr, kc)) = sr_[i].ks1; } while (0)
#define SWAIT() asm volatile("s_waitcnt vmcnt(4)" ::: "memory")
#define RESC(a) do { if (__any((a) < 1.f)) { if (hi == 0) al_l[r32] = (a); asm volatile("s_waitcnt lgkmcnt(0)" ::: "memory"); \
    _Pragma("unroll") for (int d = 0; d < 4; ++d) _Pragma("unroll") for (int r = 0; r < 16; ++r) o[d][r] *= al_l[crow(r, hi)]; } } while (0)
    f32x16 pA0, pA1, pB0, pB1; float mnA, mnB, alA, alB; bf16x8 pa0, pa1, pa2, pa3;
    __syncthreads();
    SLOAD(0, 0); asm volatile("s_waitcnt vmcnt(0)" ::: "memory"); SWRITE(0, 0); __syncthreads();
    qkt(pA0, pA1, K_lds, qr, r32, hi); partialSM(pA0, pA1, m_reg, mnA, alA, relq, hi, lut);
    SLOAD(1, KVBLK); SLOAD(0, 2 * KVBLK);
    SWAIT(); SWRITE(1, 1); __syncthreads();
    {
        SBAR(); qkt(pB0, pB1, K_lds + SHM_K, qr, r32, hi);
        finishSM(pA0, pA1, alA, l_reg, pa0, pa1, pa2, pa3); SBAR();
        SLOAD(1, 3 * KVBLK); SBAR();
        pv_d0(o, vb0, pa0, pa1, pa2, pa3); partialSM(pB0, pB1, m_reg, mnB, alB, relq - 64, hi, lut);
        __syncthreads(); SWAIT(); SWRITE(0, 0);
        RESC(alB); __syncthreads();
        SBAR(); qkt(pA0, pA1, K_lds, qr, r32, hi);
        finishSM(pB0, pB1, alB, l_reg, pa0, pa1, pa2, pa3); SBAR();
        pv_d0(o, vb0 + SHM_V, pa0, pa1, pa2, pa3); partialSM(pA0, pA1, m_reg, mnA, alA, relq - 128, hi, lut);
        __syncthreads(); asm volatile("s_waitcnt vmcnt(0)" ::: "memory"); SWRITE(1, 1);
        RESC(alA); __syncthreads();
    }
    SBAR(); qkt(pB0, pB1, K_lds + SHM_K, qr, r32, hi);
    finishSM(pA0, pA1, alA, l_reg, pa0, pa1, pa2, pa3); SBAR();
    pv_d0(o, vb0, pa0, pa1, pa2, pa3); partialSM(pB0, pB1, m_reg, mnB, alB, relq - 192, hi, lut);
    __syncthreads(); RESC(alB);
    finishSM(pB0, pB1, alB, l_reg, pa0, pa1, pa2, pa3); SBAR();
    pv_d0(o, vb0 + SHM_V, pa0, pa1, pa2, pa3);
    if (hi == 0) li_l[r32] = l_reg; asm volatile("s_waitcnt lgkmcnt(0)" ::: "memory");
#pragma unroll
    for (int r = 0; r < 16; ++r) { const int orow = crow(r, hi); const float rl = __builtin_amdgcn_rcpf(li_l[orow]);
#pragma unroll
        for (int d0 = 0; d0 < 4; ++d0) *(LAS bf16*)(ost + orow * OST_STRIDE + (d0 * 32 + r32) * 2) = (bf16)(cvt_pk_bf16(o[d0][r] * rl, 0.f) & 0xffffu); }
    asm volatile("s_waitcnt lgkmcnt(0)" ::: "memory");
    const size_t rowbase = (((size_t)(b * 8 + h) * SEQ + qpos) * 4 + pick);
    if (hi == 0 && valid) ML[rowbase] = (f32x2){m_reg, l_reg};
    { int lq = lane >> 4, lc = lane & 15; asm volatile("" : "+v"(lq), "+v"(lc));
      const LAS char* rbp = ost + lq * OST_STRIDE + lc * 16;
      const unsigned rbu = (unsigned)rowbase;
#pragma unroll
      for (int it = 0; it < 8; ++it) { const int row = it * 4 + lq;
        const unsigned rb = (unsigned)__shfl((int)rbu, row); const int vld = __shfl((int)valid, row);
        const u32x4 w = *(const LAS u32x4*)(rbp + it * 4 * OST_STRIDE);
        if (vld) *(u32x4*)(OP + (size_t)rb * HD + lc * 8) = w; } }
#undef SLOAD
#undef SWRITE
#undef SWAIT
#undef RESC
}
}

__device__ __forceinline__ void p3b_attention(Frame& F) {
    LAS char* lds = (LAS char*)F.lds;
    LAS int* pre = (LAS int*)(lds + att::PRE_OFF);
    LAS int* wtot = (LAS int*)(lds + att::WS_OFF);
    LAS float* lut = (LAS float*)(lds + att::LUT_OFF);
    const unsigned* acnt = F.ctl + CW_ACNT;
    {
        const int cnt = (int)acnt[F.tid]; int v = 1 + (cnt + 255) / 256;
#pragma unroll
        for (int o = 1; o < 64; o <<= 1) { const int t = __shfl_up(v, o); if (F.lane >= o) v += t; }
        if (F.lane == 63) wtot[F.wave] = v;
        __syncthreads();
        int offs = 0; for (int w = 0; w < F.wave; ++w) offs += wtot[w];
        pre[F.tid + 1] = offs + v; if (F.tid == 0) pre[0] = 0;
        __syncthreads();
    }
    const int T = pre[512];
    const int lo = (int)(((long)F.vcu * T) / F.G), hiT = (int)(((long)(F.vcu + 1) * T) / F.G);
    int curh = -1;
    for (int g = lo; g < hiT; ++g) {
        int a = 0, bnd = 512; while (bnd - a > 1) { const int mid = (a + bnd) >> 1; if (pre[mid] <= g) a = mid; else bnd = mid; }
        const int L = a, ti = g - pre[L], b = L >> 8, h = (L >> 5) & 7, j = L & 31, n = 256 + (int)acnt[L];
        if (h != curh) { __syncthreads(); curh = h;
            for (int idx = F.tid; idx < 513; idx += NTHR) { float v;
                if (idx == 0) v = -INFINITY;
                else { const int rel = idx - 1; int bk = rel;
                    if (rel >= 16) { bk = 16 + (int)(logf((float)rel * (1.0f / 16.0f)) / 2.0794415416798357f * 16.0f); bk = bk > 31 ? 31 : bk; }
                    v = F.rel_bias[bk * 8 + h] * LOG2E; }
                lut[idx] = v; }
        }
        att::attn_tile(lds, F.wave, (const unsigned*)(F.ws + WS_LISTS) + list_base(b, h, j), n, ti, b, h, j,
                       (const bf16*)(F.ws + WS_Q), (const bf16*)(F.ws + WS_K), (const bf16*)(F.ws + WS_V), (bf16*)(F.ws + WS_OPART), (f32x2*)(F.ws + WS_ML));
    }
    __syncthreads();
}

__device__ __forceinline__ void p3c_combine(Frame& F) {
    const int gw = F.vcu * NWAVES + F.wave, NGW = F.G * NWAVES;
    const bf16* OP = (const bf16*)(F.ws + WS_OPART); const f32x2* ML = (const f32x2*)(F.ws + WS_ML); bf16* YATT = (bf16*)(F.ws + WS_YATT);
    const int h = F.lane >> 3, dch = F.lane & 7;
    for (int m = gw; m < MTOK; m += NGW) { const int b = m / SEQ, s = m % SEQ;
        const size_t rb = ((size_t)(b * 8 + h) * SEQ + s) * 4;
        f32x2 ml[4]; float M = -1e30f;
#pragma unroll
        for (int p = 0; p < 4; ++p) { ml[p] = ML[rb + p]; if (ml[p].y > 0.f) M = fmaxf(M, ml[p].x); }
        float acc[16]; float wsum = 0.f;
#pragma unroll
        for (int e = 0; e < 16; ++e) acc[e] = 0.f;
#pragma unroll
        for (int p = 0; p < 4; ++p) if (ml[p].y > 0.f) { const float w = ml[p].y * __builtin_amdgcn_exp2f(ml[p].x - M); wsum += w;
            const u32x4* src = (const u32x4*)(OP + (rb + p) * HD + dch * 16); const u32x4 a = src[0], c = src[1];
            const unsigned wv[8] = {a.x, a.y, a.z, a.w, c.x, c.y, c.z, c.w};
#pragma unroll
            for (int e = 0; e < 8; ++e) { acc[2 * e] += w * bf_lo(wv[e]); acc[2 * e + 1] += w * bf_hi(wv[e]); } }
        const float inv = 1.0f / wsum;
        u32x4 o0, o1;
        o0.x = cvt_pk_bf16(acc[0] * inv, acc[1] * inv); o0.y = cvt_pk_bf16(acc[2] * inv, acc[3] * inv); o0.z = cvt_pk_bf16(acc[4] * inv, acc[5] * inv); o0.w = cvt_pk_bf16(acc[6] * inv, acc[7] * inv);
        o1.x = cvt_pk_bf16(acc[8] * inv, acc[9] * inv); o1.y = cvt_pk_bf16(acc[10] * inv, acc[11] * inv); o1.z = cvt_pk_bf16(acc[12] * inv, acc[13] * inv); o1.w = cvt_pk_bf16(acc[14] * inv, acc[15] * inv);
        u32x4* dst = (u32x4*)(YATT + (size_t)m * DATT + h * HD + dch * 16); dst[0] = o0; dst[1] = o1; }
}

__device__ __forceinline__ void p6_route(Frame& F) {
    {
        LAS float* scr = (LAS float*)(F.lds + F.wave * 16384);
        const int gw = F.vcu * NWAVES + F.wave, NGW = F.G * NWAVES;
        bf16* W13T = (bf16*)(F.ws + WS_W13T); bf16* W2T = (bf16*)(F.ws + WS_W2T);
#define P6_ITEM(it, T) do { const int which = (it) >> 13, r = (it) & 8191, e = r >> 9, q = r & 511; \
        if (which < 2) { const int kb = q >> 4, nb = q & 15, n0 = 32 * nb; \
            T = TrItem{(which ? F.w_eu : F.w_eg) + (size_t)e * DM * DE, W13T, DE, DM, 64 * kb, n0, e * 1024 + 256 * (n0 >> 7) + which * 128 + (n0 & 127)}; } \
        else { const int kb = q >> 6, nb = q & 63; T = TrItem{F.w_ed + (size_t)e * DE * DM, W2T, DM, DE, 64 * kb, 32 * nb, e * 2048 + 32 * nb}; } } while (0)
        TRANSPOSE_LOOP(gw, NGW, 3 * 8192, P6_ITEM);
#undef P6_ITEM
    }
    __syncthreads();
    LAS float* pbuf = (LAS float*)F.lds;
    LAS float* lg = (LAS float*)(F.lds + 16384);
    LAS int* lcnt = (LAS int*)(F.lds + 24576); LAS int* gb = lcnt + 16;
    LAS float* rinfo = (LAS float*)(F.lds + 24832);
    const float* x1 = F.out; const float* SSQ = (const float*)(F.ws + WS_SSQ); const float* A2 = (const float*)(F.ws + WS_A2);
    const float* mod = (const float*)(F.ws + WS_MOD); const bf16* WR = (const bf16*)(F.ws + WS_WR); const float* RC = (const float*)(F.ws + WS_RCONST);
    bf16* H2 = (bf16*)(F.ws + WS_H2);
    for (int rb = F.vcu * 64; rb < MTOK; rb += F.G * 64) {
        const int bk = F.wave >> 1, kh = F.wave & 1, r = F.lane & 15, g4 = F.lane >> 4, row = rb + bk * 16 + r, b = row / SEQ;
        if (F.tid < 16) lcnt[F.tid] = 0;
        float rstd;
        { const f32x4 s0 = *(const f32x4*)(SSQ + (size_t)row * 32 + g4 * 8), s1 = *(const f32x4*)(SSQ + (size_t)row * 32 + g4 * 8 + 4);
          float s = ((s0.x + s0.y) + (s0.z + s0.w)) + ((s1.x + s1.y) + (s1.z + s1.w)); s += __shfl_xor(s, 16); s += __shfl_xor(s, 32);
          rstd = 1.0f / sqrtf(s * (1.0f / DM) + EPS); }
        f32x4 acc0 = {0.f, 0.f, 0.f, 0.f}, acc1 = {0.f, 0.f, 0.f, 0.f};
        const float* xr = x1 + (size_t)row * DM; const float* a2p = A2 + b * DM; const float* shp = mod + b * (6 * DM) + 3 * DM;
        const bf16* wh0 = WR + ((size_t)(b * 2 + 0) * 32 + r) * DM, * wl0 = WR + ((size_t)(b * 2 + 1) * 32 + r) * DM;
        for (int it0 = 0; it0 < 32; it0 += 4) {
            f32x4 xa[4], xb[4], aa[4], ab[4], sa[4], sb[4]; bf16x8 bh0[4], bl0[4], bh1[4], bl1[4];
#pragma unroll
            for (int u = 0; u < 4; ++u) { const int kk = kh * 1024 + (it0 + u) * 32 + 8 * g4;
                xa[u] = *(const f32x4*)(xr + kk); xb[u] = *(const f32x4*)(xr + kk + 4);
                aa[u] = *(const f32x4*)(a2p + kk); ab[u] = *(const f32x4*)(a2p + kk + 4); sa[u] = *(const f32x4*)(shp + kk); sb[u] = *(const f32x4*)(shp + kk + 4);
                bh0[u] = *(const bf16x8*)(wh0 + kk); bl0[u] = *(const bf16x8*)(wl0 + kk); bh1[u] = *(const bf16x8*)(wh0 + 16 * DM + kk); bl1[u] = *(const bf16x8*)(wl0 + 16 * DM + kk); }
#pragma unroll
            for (int u = 0; u < 4; ++u) { const int kk = kh * 1024 + (it0 + u) * 32 + 8 * g4;
                const f32x4 ha = xa[u] * rstd * aa[u] + sa[u], hb = xb[u] * rstd * ab[u] + sb[u];
                u32x4 hw; hw.x = cvt_pk_bf16(ha.x, ha.y); hw.y = cvt_pk_bf16(ha.z, ha.w); hw.z = cvt_pk_bf16(hb.x, hb.y); hw.w = cvt_pk_bf16(hb.z, hb.w);
                *(u32x4*)(H2 + (size_t)row * DM + kk) = hw;
                u32x4 xh; xh.x = cvt_pk_bf16(xa[u].x, xa[u].y); xh.y = cvt_pk_bf16(xa[u].z, xa[u].w); xh.z = cvt_pk_bf16(xb[u].x, xb[u].y); xh.w = cvt_pk_bf16(xb[u].z, xb[u].w);
                u32x4 xl; xl.x = cvt_pk_bf16(xa[u].x - bf_lo(xh.x), xa[u].y - bf_hi(xh.x)); xl.y = cvt_pk_bf16(xa[u].z - bf_lo(xh.y), xa[u].w - bf_hi(xh.y));
                xl.z = cvt_pk_bf16(xb[u].x - bf_lo(xh.z), xb[u].y - bf_hi(xh.z)); xl.w = cvt_pk_bf16(xb[u].z - bf_lo(xh.w), xb[u].w - bf_hi(xh.w));
                const bf16x8 ah = __builtin_bit_cast(bf16x8, xh), al = __builtin_bit_cast(bf16x8, xl);
                acc0 = __builtin_amdgcn_mfma_f32_16x16x32_bf16(ah, bh0[u], acc0, 0, 0, 0); acc0 = __builtin_amdgcn_mfma_f32_16x16x32_bf16(al, bh0[u], acc0, 0, 0, 0); acc0 = __builtin_amdgcn_mfma_f32_16x16x32_bf16(ah, bl0[u], acc0, 0, 0, 0);
                acc1 = __builtin_amdgcn_mfma_f32_16x16x32_bf16(ah, bh1[u], acc1, 0, 0, 0); acc1 = __builtin_amdgcn_mfma_f32_16x16x32_bf16(al, bh1[u], acc1, 0, 0, 0); acc1 = __builtin_amdgcn_mfma_f32_16x16x32_bf16(ah, bl1[u], acc1, 0, 0, 0); }
        }
#pragma unroll
        for (int e = 0; e < 4; ++e) { pbuf[((bk * 2 + kh) * 16 + 4 * g4 + e) * 32 + r] = acc0[e]; pbuf[((bk * 2 + kh) * 16 + 4 * g4 + e) * 32 + 16 + r] = acc1[e]; }
        __syncthreads();
        if (kh == 0 && F.lane < 16) {
            const int lrow = bk * 16 + F.lane;
            for (int c = 0; c < 20; ++c) lg[lrow * 32 + c] = rstd * (pbuf[((bk * 2 + 0) * 16 + F.lane) * 32 + c] + pbuf[((bk * 2 + 1) * 16 + F.lane) * 32 + c]) + RC[b * 32 + c];
            int gi = 0; float gm = lg[lrow * 32];
            for (int c = 1; c < 4; ++c) { const float v = lg[lrow * 32 + c]; if (v > gm) { gm = v; gi = c; } }
            float gs = 0.f; for (int c = 0; c < 4; ++c) gs += expf(lg[lrow * 32 + c] - gm);
            const float gp = 1.0f / gs;
            const LAS float* el = lg + lrow * 32 + 4 + 4 * gi;
            int i0 = 0; float m0 = el[0]; for (int c = 1; c < 4; ++c) if (el[c] > m0) { m0 = el[c]; i0 = c; }
            int i1 = -1; float m1 = -INFINITY; for (int c = 0; c < 4; ++c) if (c != i0 && el[c] > m1) { m1 = el[c]; i1 = c; }
            const float t = expf(m1 - m0), w0 = gp / (1.0f + t), w1 = gp * t / (1.0f + t);
            const int e0 = 4 * gi + i0, e1 = 4 * gi + i1;
            const int p0 = atomicAdd((int*)&lcnt[e0], 1), p1 = atomicAdd((int*)&lcnt[e1], 1);
            LAS float* ri = rinfo + lrow * 8; ri[0] = __int_as_float(e0); ri[1] = __int_as_float(p0); ri[2] = w0; ri[3] = __int_as_float(e1); ri[4] = __int_as_float(p1); ri[5] = w1;
        }
        __syncthreads();
        if (F.tid < 16) { const int n = lcnt[F.tid]; gb[F.tid] = n > 0 ? (int)atomicAdd(F.ctl + CW_ECNT + 64 * F.tid, (unsigned)n) : 0; }
        __syncthreads();
        if (F.tid < 64) { const LAS float* ri = rinfo + F.tid * 8; const unsigned tok = (unsigned)(rb + F.tid);
            unsigned* ST = (unsigned*)(F.ws + WS_SLOTTOK); float* SW = (float*)(F.ws + WS_SLOTW);
            const int e0 = __float_as_int(ri[0]), e1 = __float_as_int(ri[3]);
            const int s0 = e0 * 16384 + gb[e0] + __float_as_int(ri[1]), s1 = e1 * 16384 + gb[e1] + __float_as_int(ri[4]);
            ST[s0] = tok; SW[s0] = ri[2]; ST[s1] = tok | 0x10000u; SW[s1] = ri[5]; }
        __syncthreads();
    }
}

__device__ __forceinline__ void moe_table(Frame& F, LAS int* tab) {
    __syncthreads();
    if (F.tid == 0) { int acc = 0; for (int e = 0; e < 16; ++e) { const int n = (int)F.ctl[CW_ECNT + 64 * e]; tab[e] = acc; tab[32 + e] = n; acc += (n + 255) >> 8; } tab[16] = acc; }
    __syncthreads();
}

__device__ __forceinline__ void p9_final(Frame& F) {
    const int gw = F.vcu * NWAVES + F.wave, NGW = F.G * NWAVES;
    const float* mod = (const float*)(F.ws + WS_MOD); const bf16* O0 = (const bf16*)(F.ws + WS_O0); const bf16* O1 = (const bf16*)(F.ws + WS_O1);
    int curb = -1; f32x4 gv[8], fw[8];
#pragma unroll
    for (int j = 0; j < 8; ++j) fw[j] = *(const f32x4*)(F.final_w + 4 * F.lane + 256 * j);
    for (int m = gw; m < MTOK; m += 2 * NGW) {
        const int b = m / SEQ;
        if (b != curb) { curb = b;
#pragma unroll
            for (int j = 0; j < 8; ++j) gv[j] = *(const f32x4*)(mod + b * (6 * DM) + 5 * DM + 4 * F.lane + 256 * j); }
        f32x4* xr0 = (f32x4*)(F.out + (size_t)m * DM) + F.lane; f32x4* xr1 = (f32x4*)(F.out + (size_t)(m + NGW) * DM) + F.lane;
        const u32x2* p00 = (const u32x2*)(O0 + (size_t)m * DM) + F.lane; const u32x2* p01 = (const u32x2*)(O1 + (size_t)m * DM) + F.lane;
        const u32x2* p10 = (const u32x2*)(O0 + (size_t)(m + NGW) * DM) + F.lane; const u32x2* p11 = (const u32x2*)(O1 + (size_t)(m + NGW) * DM) + F.lane;
        f32x4 v0[8], v1[8]; u32x2 a0[8], c0[8], a1[8], c1[8]; float s0 = 0.f, s1 = 0.f;
#pragma unroll
        for (int j = 0; j < 8; ++j) { v0[j] = xr0[64 * j]; a0[j] = p00[64 * j]; c0[j] = p01[64 * j]; v1[j] = xr1[64 * j]; a1[j] = p10[64 * j]; c1[j] = p11[64 * j]; }
#pragma unroll
        for (int j = 0; j < 8; ++j) {
            const f32x4 y0 = {bf_lo(a0[j].x) + bf_lo(c0[j].x), bf_hi(a0[j].x) + bf_hi(c0[j].x), bf_lo(a0[j].y) + bf_lo(c0[j].y), bf_hi(a0[j].y) + bf_hi(c0[j].y)};
            const f32x4 y1 = {bf_lo(a1[j].x) + bf_lo(c1[j].x), bf_hi(a1[j].x) + bf_hi(c1[j].x), bf_lo(a1[j].y) + bf_lo(c1[j].y), bf_hi(a1[j].y) + bf_hi(c1[j].y)};
            v0[j] = v0[j] + gv[j] * y0; v1[j] = v1[j] + gv[j] * y1;
            s0 += (v0[j].x * v0[j].x + v0[j].y * v0[j].y) + (v0[j].z * v0[j].z + v0[j].w * v0[j].w); s1 += (v1[j].x * v1[j].x + v1[j].y * v1[j].y) + (v1[j].z * v1[j].z + v1[j].w * v1[j].w); }
        const float r0 = 1.0f / sqrtf(wave_sum(s0) * (1.0f / DM) + EPS), r1 = 1.0f / sqrtf(wave_sum(s1) * (1.0f / DM) + EPS);
#pragma unroll
        for (int j = 0; j < 8; ++j) { xr0[64 * j] = v0[j] * r0 * fw[j]; xr1[64 * j] = v1[j] * r1 * fw[j]; }
    }
}

constexpr int N_PHASES = 12;
struct Args { const float* in[21]; float* out; unsigned char* ws; int ph_lo, ph_hi; };
__global__ void __launch_bounds__(NTHR, 2) fwd_kernel(Args args) {
    extern __shared__ __attribute__((aligned(16))) unsigned char lds_raw[];
    Frame F;
    F.lds = (LAS unsigned char*)lds_raw; F.MISC = (volatile LAS unsigned*)(F.lds + MISC_OFF);
    F.wave = __builtin_amdgcn_readfirstlane(threadIdx.x >> 6); F.lane = lane_id(); F.tid = F.wave * 64 + F.lane;
    F.G = gridDim.x; { const int bx = blockIdx.x; F.vcu = (F.G % 8 == 0) ? (bx % 8) * (F.G / 8) + bx / 8 : bx; }
    F.ws = args.ws; F.ctl = (unsigned*)(args.ws + WS_CTL); F.out = args.out;
    F.x = args.in[0]; F.c = args.in[1]; F.w_ada = args.in[2]; F.b_ada = args.in[3]; F.norm1_w = args.in[4]; F.norm2_w = args.in[5]; F.final_w = args.in[6]; F.w_in = args.in[7];
    F.sg_ln_w = args.in[8]; F.sg_ln_b = args.in[9]; F.w_spatial = args.in[10]; F.b_spatial = args.in[11]; F.rel_bias = args.in[12]; F.w_out_sg = args.in[13]; F.w_out_att = args.in[14];
    F.w_o = args.in[15]; F.w_rg = args.in[16]; F.w_re = args.in[17]; F.w_eg = args.in[18]; F.w_eu = args.in[19]; F.w_ed = args.in[20];
    for (int u = F.tid; u < (LDS_BYTES - MISC_OFF) / 4; u += NTHR) ((LAS unsigned*)(F.lds + MISC_OFF))[u] = 0u;
    __syncthreads();
    const int lo = args.ph_lo, hi = args.ph_hi;
    XcdBarrier bar; bar.bar = F.ctl + CW_BAR; bar.x = 0; bar.st = nullptr; bar.wid = F.wave;
    if (hi - lo > 1) bar = xcd_barrier_post(F.ctl + CW_BAR, F.MISC + 8, F.wave);
#ifndef PHASE_MASK
#define PHASE_MASK 0xFFF
#endif
#define IN(k) (((PHASE_MASK >> (k)) & 1) && lo <= (k) && (k) < hi && ((F.lane = lane_id()), (F.tid = F.wave * 64 + F.lane), true))
#define SEAM(k) do { if (IN(k) && IN((k) + 1)) xcd_barrier(bar); } while (0)
#ifndef REPEAT_MASK
#define REPEAT_MASK 0
#endif
    LAS int* tab = (LAS int*)(F.lds + TAB_OFF);

#define BODY_0 { p0_prologue(F); }
#define BODY_1 { p1_norm1(F); }
#define BODY_2 { SchedGrid S{(const char*)(F.ws + WS_H), (const char*)(F.ws + WS_WINT), 36, 64 * 36, F.G, F.vcu, (size_t)256 * DM * 2, (size_t)256 * DM * 2}; \
        EpiProj E{F.ws, (float*)(F.ctl + CW_KSUM)}; \
        pg8::gemm_phase<DM, true, false>(F.lds, F.wave, S, E); }
#define BODY_3 { for (int u = F.vcu; u < 256; u += F.G) sgu_unit(F, u >> 7, (u >> 1) & 63, u & 1); \
        for (int u = F.vcu; u < 512; u += F.G) { const int i5 = u & 31; select_unit(F, u >> 8, (u >> 5) & 7, (u & 256) ? 31 - i5 : i5); } }
#define BODY_4 { p3b_attention(F); }
#define BODY_5 { p3c_combine(F); }
#define BODY_6 { SchedPair S{(const char*)(F.ws + WS_YSG), (const char*)(F.ws + WS_YATT), (const char*)(F.ws + WS_WOSGT), (const char*)(F.ws + WS_WOATTT), F.G, F.vcu}; \
        EpiMerge E{(const bf16*)(F.ws + WS_GS), (const bf16*)(F.ws + WS_GA), (bf16*)(F.ws + WS_MERGED)}; \
        pg8::gemm_phase<1024, true, false>(F.lds, F.wave, S, E); }
#define BODY_7 { SchedGrid S{(const char*)(F.ws + WS_MERGED), (const char*)(F.ws + WS_WOT), 8, 64 * 8, F.G, F.vcu, (size_t)256 * DM * 2, (size_t)256 * DM * 2}; \
        EpiX1 E{F.x, (const float*)(F.ws + WS_MOD), F.out, (float*)(F.ws + WS_SSQ)}; \
        pg8::gemm_phase<DM, false, false>(F.lds, F.wave, S, E); }
#define BODY_8 { p6_route(F); }
#define BODY_9 { moe_table(F, tab); \
        SchedMoe S{(const unsigned*)(F.ws + WS_SLOTTOK), (const char*)(F.ws + WS_H2), (const char*)(F.ws + WS_W13T), tab, F.G, F.vcu, 2, (size_t)1024 * DM * 2, (size_t)256 * DM * 2, 0}; \
        EpiSwiglu E{(bf16*)(F.ws + WS_ACT)}; \
        pg8::gemm_phase<DM, true, true>(F.lds, F.wave, S, E); }
#define BODY_10 { moe_table(F, tab); \
        SchedMoe S{(const unsigned*)(F.ws + WS_SLOTTOK), (const char*)(F.ws + WS_ACT), (const char*)(F.ws + WS_W2T), tab, F.G, F.vcu, 3, (size_t)DM * DE * 2, (size_t)256 * DE * 2, (size_t)256 * DE * 2}; \
        EpiDown E{(const unsigned*)(F.ws + WS_SLOTTOK), (const float*)(F.ws + WS_SLOTW), tab, (bf16*)(F.ws + WS_O0), (bf16*)(F.ws + WS_O1)}; \
        pg8::gemm_phase<DE, true, false>(F.lds, F.wave, S, E); }
#define BODY_11 { p9_final(F); }
#ifndef PROBE_MASK
#define PROBE_MASK 0
#endif
#define STAMP(k) do { if (PROBE_MASK && blockIdx.x == 0 && F.tid == 0) { const unsigned long long t_ = __builtin_amdgcn_s_memrealtime(); F.MISC[32 + 2 * (k)] = (unsigned)t_; F.MISC[33 + 2 * (k)] = (unsigned)(t_ >> 32); } } while (0)
#define RUN(k) do { if (IN(k)) { BODY_##k; if ((REPEAT_MASK >> (k)) & 1) { xcd_barrier(bar); BODY_##k; } } SEAM(k); STAMP((k) + 1); } while (0)
    STAMP(0);
    RUN(0); RUN(1); RUN(2); RUN(3); RUN(4); RUN(5); RUN(6); RUN(7); RUN(8); RUN(9); RUN(10);
    if (IN(11)) { BODY_11; }
    STAMP(12);
    if (PROBE_MASK && blockIdx.x == 0 && F.tid == 0) {
        unsigned long long tot = 0;
        for (int k = 0; k < 12; ++k) if ((PROBE_MASK >> k) & 1) { const unsigned long long a = ((unsigned long long)F.MISC[33 + 2 * k] << 32) | F.MISC[32 + 2 * k], b = ((unsigned long long)F.MISC[35 + 2 * k] << 32) | F.MISC[34 + 2 * k]; tot += b - a; }
        const unsigned long long t0 = __builtin_amdgcn_s_memrealtime();
        while (__builtin_amdgcn_s_memrealtime() - t0 < 8ull * tot) __builtin_amdgcn_s_sleep(8);
    }
#undef IN
#undef SEAM
}

extern "C" void kernel_launch(void* const* d_in, const int* in_sizes, int n_in, void* d_out, int out_size, void* d_ws, size_t ws_size, hipStream_t stream) {
    static int grid = 0;
    if (grid == 0) {
        if (n_in != 21 || in_sizes[0] != MTOK * DM || out_size != MTOK * DM || ws_size < WS_END) {
            fprintf(stderr, "kernel_launch: unexpected shapes (n_in %d, in0 %d, out %d, ws %zu, need ws >= %zu); nothing launched\n", n_in, n_in > 0 ? in_sizes[0] : -1, out_size, ws_size, (size_t)WS_END); grid = -1; return; }
        int dev = 0, cus = 0, per_cu = 0;
        if (hipGetDevice(&dev) != hipSuccess || hipDeviceGetAttribute(&cus, hipDeviceAttributeMultiprocessorCount, dev) != hipSuccess) { grid = -1; return; }
        if (hipFuncSetAttribute((const void*)fwd_kernel, hipFuncAttributeMaxDynamicSharedMemorySize, LDS_BYTES) != hipSuccess) { fprintf(stderr, "kernel_launch: hipFuncSetAttribute failed\n"); grid = -1; return; }
        if (hipOccupancyMaxActiveBlocksPerMultiprocessor(&per_cu, (const void*)fwd_kernel, NTHR, LDS_BYTES) != hipSuccess || per_cu < 1) { fprintf(stderr, "kernel_launch: occupancy query says %d\n", per_cu); }
        (void)hipGetLastError();
        grid = cus;
    }
    if (grid < 0) return;
    if (hipMemsetAsync((char*)d_ws + WS_CTL, 0, CTL_ZERO_BYTES, stream) != hipSuccess) return;
    Args a{};
    for (int i = 0; i < 21; ++i) a.in[i] = (const float*)d_in[i];
    a.out = (float*)d_out; a.ws = (unsigned char*)d_ws;
#if MK_N_LAUNCHES == 1
    a.ph_lo = 0; a.ph_hi = N_PHASES;
    hipLaunchKernelGGL(fwd_kernel, dim3(grid), dim3(NTHR), LDS_BYTES, stream, a);
#else
    for (int p = 0; p < N_PHASES; ++p) { a.ph_lo = p; a.ph_hi = p + 1; hipLaunchKernelGGL(fwd_kernel, dim3(grid), dim3(NTHR), LDS_BYTES, stream, a); }
#endif
    const hipError_t le = hipPeekAtLastError();
    if (le != hipSuccess) fprintf(stderr, "kernel_launch: launch failed: %s\n", hipGetErrorName(le));
}
```

```cpp
#include <hip/hip_runtime.h>
#include <cstdio>
#include <cstdint>

#ifndef MK_N_LAUNCHES
#define MK_N_LAUNCHES 1
#endif

#define GAS __attribute__((address_space(1)))
#define LAS __attribute__((address_space(3)))
typedef unsigned short bf16;
typedef short bf16x8 __attribute__((ext_vector_type(8)));
typedef short s16x4 __attribute__((ext_vector_type(4)));
typedef float f32x2 __attribute__((ext_vector_type(2)));
typedef float f32x4 __attribute__((ext_vector_type(4)));
typedef float f32x16 __attribute__((ext_vector_type(16)));
typedef unsigned u32x2 __attribute__((ext_vector_type(2)));
typedef unsigned u32x4 __attribute__((ext_vector_type(4)));

constexpr int BATCH = 2, SEQ = 8192, DM = 2048, MTOK = BATCH * SEQ;
constexpr int DSG = 1024, DATT = 1024, NH = 8, HD = 128, NBLK = 32, INCOLS = 9216;
constexpr int NE = 16, DE = 512;
constexpr float EPS = 1e-6f;
constexpr float LOG2E = 1.4426950408889634f;
constexpr int NWAVES = 8, NTHR = 512;

constexpr size_t MiB = 1u << 20;
constexpr size_t WS_CTL = 0, CTL_ZERO_BYTES = 1 * MiB;
constexpr size_t WS_MOD = 1 * MiB;
constexpr size_t WS_RCONST = 1 * MiB + 128 * 1024;
constexpr size_t WS_A2 = 1 * MiB + 192 * 1024;
constexpr size_t WS_WR = 1 * MiB + 256 * 1024;
constexpr size_t WS_MODP = 2 * MiB;
constexpr size_t WS_SSQ = 488 * MiB;
constexpr size_t WS_SLOTTOK = 4 * MiB;
constexpr size_t WS_SLOTW = 5 * MiB;
constexpr size_t WS_ML = 6 * MiB;
constexpr size_t WS_LISTS = 10 * MiB;
constexpr size_t WS_WINT = 20 * MiB;
constexpr size_t WS_WOSGT = 56 * MiB;
constexpr size_t WS_WOATTT = 60 * MiB;
constexpr size_t WS_WOT = 64 * MiB;
constexpr size_t WS_H = 72 * MiB;
constexpr size_t WS_U = 136 * MiB;
constexpr size_t WS_VG = 168 * MiB;
constexpr size_t WS_Q = 200 * MiB;
constexpr size_t WS_K = 232 * MiB;
constexpr size_t WS_V = 264 * MiB;
constexpr size_t WS_GS = 296 * MiB;
constexpr size_t WS_GA = 360 * MiB;
constexpr size_t WS_YSG = 424 * MiB;
constexpr size_t WS_YATT = 456 * MiB;
constexpr size_t WS_END = 490 * MiB;
constexpr size_t WS_OPART = 72 * MiB;
constexpr size_t WS_MERGED = 200 * MiB;
constexpr size_t WS_TMP = 72 * MiB;
constexpr size_t WS_H2 = 72 * MiB;
constexpr size_t WS_W13T = 136 * MiB;
constexpr size_t WS_W2T = 264 * MiB;
constexpr size_t WS_ACT = 296 * MiB;
constexpr size_t WS_O0 = 332 * MiB;
constexpr size_t WS_O1 = 396 * MiB;
constexpr int LIST_PER_BH = 135168;
constexpr int CW_TMO = 0;
constexpr int CW_BAR = 4096;
constexpr int CW_ACNT = 8192;
constexpr int CW_ECNT = 9216;
constexpr int CW_KSUM = 16384;

constexpr int LDS_BYTES = 147456;
constexpr int RING_BYTES = 131072;
constexpr int TAB_OFF = 143360;
constexpr int MISC_OFF = 146432;

#define LDS_WAIT() asm volatile("s_waitcnt lgkmcnt(0)" ::: "memory")
#define VM_WAIT() asm volatile("s_waitcnt vmcnt(0)" ::: "memory")
__device__ __forceinline__ unsigned cvt_pk_bf16(float lo, float hi) { unsigned r; asm volatile("v_cvt_pk_bf16_f32 %0, %1, %2" : "=v"(r) : "v"(lo), "v"(hi)); return r; }
__device__ __forceinline__ float bf_lo(unsigned w) { return __uint_as_float(w << 16); }
__device__ __forceinline__ float bf_hi(unsigned w) { return __uint_as_float(w & 0xffff0000u); }
__device__ __forceinline__ float wave_sum(float v) {
#pragma unroll
    for (int o = 1; o < 64; o <<= 1) v += __shfl_xor(v, o);
    return v;
}
__device__ __forceinline__ f32x2 gelu_pk(f32x2 v) {
    const f32x2 av = __builtin_elementwise_abs(v), d = av * 0.2316418882f + 1.0f;
    f32x2 t; t.x = __builtin_amdgcn_rcpf(d.x); t.y = __builtin_amdgcn_rcpf(d.y);
    f32x2 q = t * 0.5307027145f + (-0.7265760135f); q = q * t + 0.7107068705f; q = q * t + (-0.142248368f); q = q * t + 0.127414796f; q = q * t;
    const f32x2 s = (v * v) * (-0.72134752044f);
    f32x2 e; e.x = __builtin_amdgcn_exp2f(s.x); e.y = __builtin_amdgcn_exp2f(s.y);
    const f32x2 m = v * (q * e), r = v - m;
    f32x2 o; o.x = v.x < 0.f ? m.x : r.x; o.y = v.y < 0.f ? m.y : r.y; return o;
}
__device__ __forceinline__ int lane_id() { return (int)__builtin_amdgcn_mbcnt_hi(~0u, __builtin_amdgcn_mbcnt_lo(~0u, 0u)); }
__device__ __forceinline__ float sigmoid_f(float x) { return __builtin_amdgcn_rcpf(1.0f + __builtin_amdgcn_exp2f(-x * LOG2E)); }

#define XB_TMO      128
#define XB_XCNT(j)  (256  + 64 * (j))
#define XB_XSUB(j)  (1280 + 64 * (j))
#define XB_XGEN(j)  (2304 + 64 * (j))
#define XB_TOP      3328
#define XB_TOPGEN   3392
#define XCD_BAR_WORDS 3456
#define XB_SPIN_CAP (1u << 18)
__device__ __forceinline__ unsigned xb_ld(unsigned* p)              { return __hip_atomic_load(p, __ATOMIC_RELAXED, __HIP_MEMORY_SCOPE_AGENT); }
__device__ __forceinline__ unsigned xb_add(unsigned* p, unsigned v) { return __hip_atomic_fetch_add(p, v, __ATOMIC_RELAXED, __HIP_MEMORY_SCOPE_AGENT); }
__device__ __forceinline__ unsigned xb_xcc_id() { return (unsigned)__builtin_amdgcn_s_getreg((3 << 11) | 20) & 0xFu; }
#define XB_SPIN(cond, bar) do { unsigned _sp = 0; while (cond) { __builtin_amdgcn_s_sleep(1); \
    if ((++_sp & 255u) == 0u) { if (xb_ld(&(bar)[XB_TMO])) break; if (_sp > XB_SPIN_CAP) { atomicAdd(&(bar)[XB_TMO], 1u); break; } } } } while (0)
struct XcdBarrier { unsigned* bar; unsigned x; volatile LAS unsigned* st; int wid; };
__device__ __forceinline__ XcdBarrier xcd_barrier_post(unsigned* bar, volatile LAS unsigned* st, int wid) {
    XcdBarrier b; b.bar = bar; b.x = xb_xcc_id(); b.st = st; b.wid = wid;
    if (wid == 0 && lane_id() == 0) (void)xb_add(&bar[XB_XCNT(b.x)], 1u);
    return b;
}
__device__ __forceinline__ void xcd_barrier_complete(unsigned* bar, unsigned x, unsigned& nloc, unsigned& nx) {
    const unsigned G = gridDim.x * gridDim.y * gridDim.z;
    unsigned sum, cnt, mine, sp = 0u;
    for (;;) {
        sum = 0u; cnt = 0u; mine = 0u;
#pragma unroll
        for (unsigned j = 0; j < 16; ++j) { const unsigned c = xb_ld(&bar[XB_XCNT(j)]); sum += c; cnt += (c > 0u) ? 1u : 0u; mine = (j == x) ? c : mine; }
        if (sum == G) break;
        __builtin_amdgcn_s_sleep(1);
        if ((++sp & 255u) == 0u) { if (xb_ld(&bar[XB_TMO])) break; if (sp > XB_SPIN_CAP) { atomicAdd(&bar[XB_TMO], 1u); break; } }
    }
    nloc = mine > 0u ? mine : 1u; nx = cnt > 0u ? cnt : 1u;
}
__device__ __forceinline__ void xcd_barrier(const XcdBarrier& b) {
    asm volatile("s_waitcnt vmcnt(0)" ::: "memory");
    __syncthreads();
    if (b.wid == 0 && lane_id() == 0) {
        unsigned* bar = b.bar;
        __builtin_amdgcn_s_waitcnt(0);
        unsigned nloc = b.st[0], nx = b.st[1];
        if (nloc == 0u) { xcd_barrier_complete(bar, b.x, nloc, nx); b.st[0] = nloc; b.st[1] = nx; }
        const unsigned old = xb_add(&bar[XB_XSUB(b.x)], 1u);
        const unsigned gen = old / nloc;
        if (old + 1u == (gen + 1u) * nloc) {
            __builtin_amdgcn_fence(__ATOMIC_RELEASE, "agent");
            asm volatile("s_waitcnt vmcnt(0)" ::: "memory");
            const unsigned og = xb_add(&bar[XB_TOP], 1u);
            const unsigned tg = og / nx;
            if (og + 1u == (tg + 1u) * nx) xb_add(&bar[XB_TOPGEN], 1u);
            else XB_SPIN(xb_ld(&bar[XB_TOPGEN]) == tg, bar);
            __builtin_amdgcn_fence(__ATOMIC_ACQUIRE, "agent");
            xb_add(&bar[XB_XGEN(b.x)], 1u);
            asm volatile("s_waitcnt vmcnt(0)" ::: "memory");
        } else {
            XB_SPIN(xb_ld(&bar[XB_XGEN(b.x)]) == gen, bar);
            __builtin_amdgcn_fence(__ATOMIC_ACQUIRE, "agent");
            asm volatile("s_waitcnt vmcnt(0)" ::: "memory");
        }
    }
    __syncthreads();
}

namespace pg8 {
constexpr int BM = 256, BK = 64, HALF = 128, HTB = HALF * BK * 2, STAGE_BYTES = 8 * HTB;
__host__ __device__ __forceinline__ int lds_byte(int r, int c) { const int st = (r >> 4) * 2 + (c >> 5), rr = r & 15, cc = c & 31, ob = rr * 64 + cc * 2; return st * 1024 + (ob ^ (((ob >> 9) & 1) << 5)); }
__host__ __device__ __forceinline__ void stage_rc(int b, int& R, int& C) { const int st = b / 1024, sb = b % 1024, swz = sb ^ (((sb >> 9) & 1) << 5); R = (st >> 1) * 16 + swz / 64; C = (st & 1) * 32 + (swz % 64) / 2; }
__host__ __device__ __forceinline__ int perm32(int rho) { const int n = rho >> 4, i = rho & 15; return 8 * (i >> 2) + 4 * n + (i & 3); }

struct Unit { const char* A; const char* B; int pm, pn, kind, aux; };

template <int K, bool PERM, bool GATHER, class Sched, class Epi>
__device__ __forceinline__ void gemm_phase(LAS unsigned char* lds, const int wid, const Sched& S, const Epi& E) {
    const int lane = lane_id(), tid = wid * 64 + lane, wr = wid >> 2, wc = wid & 3, fr = lane & 15, fq = lane >> 4;
    constexpr int nt = K / BK;
    int Rr[2], Cc[2]; unsigned voffB[2];
#pragma unroll
    for (int i = 0; i < 2; ++i) { int R, C; stage_rc(tid * 16 + i * 8192, R, C); Rr[i] = R; Cc[i] = C; const int Rb = PERM ? ((R & ~31) + perm32(R & 31)) : R; voffB[i] = (unsigned)(Rb * K + C) * 2u; }
    constexpr size_t kstep = (size_t)(BK * 2);
    constexpr size_t hstep = (size_t)HALF * K * 2;
    const unsigned ldsw = (unsigned)wid * 1024u;
    const int aoff = lds_byte(wr * 64 + fr, fq * 8), boff = lds_byte(wc * 32 + fr, fq * 8);
#define PG8_SA(b, h) (((b) * 2 + (h)) * HTB)
#define PG8_SB(b, h) ((4 + (b) * 2 + (h)) * HTB)
#define PG8_STAGE_B(b, h, gbase) do { _Pragma("unroll") for (int _i = 0; _i < 2; ++_i) \
        __builtin_amdgcn_global_load_lds((const unsigned*)((const char*)(gbase) + (size_t)(h) * hstep + voffB[_i]), (LAS unsigned*)(lds + PG8_SB(b, h) + ldsw + _i * 8192), 16, 0, 0); } while (0)
#define PG8_STAGE_A(b, h, gbase, VO) do { _Pragma("unroll") for (int _i = 0; _i < 2; ++_i) \
        __builtin_amdgcn_global_load_lds((const unsigned*)((const char*)(gbase) + (VO)[h][_i]), (LAS unsigned*)(lds + PG8_SA(b, h) + ldsw + _i * 8192), 16, 0, 0); } while (0)
#define PG8_LDA(dst, b, h) do { _Pragma("unroll") for (int m = 0; m < 4; ++m) _Pragma("unroll") for (int k = 0; k < 2; ++k) dst[m][k] = *(const LAS bf16x8*)(lds + PG8_SA(b, h) + aoff + m * 2048 + k * 1024); } while (0)
#define PG8_LDB(dst, b, h) do { _Pragma("unroll") for (int n = 0; n < 2; ++n) _Pragma("unroll") for (int k = 0; k < 2; ++k) dst[n][k] = *(const LAS bf16x8*)(lds + PG8_SB(b, h) + boff + n * 2048 + k * 1024); } while (0)
#define PG8_MMA(ai, bj, At, Bt) do { __builtin_amdgcn_s_setprio(1); _Pragma("unroll") for (int m = 0; m < 4; ++m) _Pragma("unroll") for (int n = 0; n < 2; ++n) _Pragma("unroll") for (int k = 0; k < 2; ++k) \
        acc[ai][bj][m][n] = __builtin_amdgcn_mfma_f32_16x16x32_bf16(Bt[n][k], At[m][k], acc[ai][bj][m][n], 0, 0, 0); __builtin_amdgcn_s_setprio(0); } while (0)
#define PG8_WAIT_V(n) asm volatile("s_waitcnt vmcnt(" #n ")" ::: "memory")
#define PG8_WAIT_L(n) asm volatile("s_waitcnt lgkmcnt(" #n ")" ::: "memory")
#define PG8_BAR __builtin_amdgcn_s_barrier()
#define PG8_SCHED __builtin_amdgcn_sched_barrier(0)
#define PG8_SETVO(VO, U) do { _Pragma("unroll") for (int _h = 0; _h < 2; ++_h) _Pragma("unroll") for (int _i = 0; _i < 2; ++_i) { \
        if constexpr (GATHER) (VO)[_h][_i] = ((unsigned)S.row_of((U), _h * HALF + Rr[_i]) * (unsigned)K + (unsigned)Cc[_i]) * 2u; \
        else (VO)[_h][_i] = (unsigned)(((_h * HALF + Rr[_i]) * K + Cc[_i]) * 2); } } while (0)
    Unit cur, nxt; int ui = 0;
    if (!S.next(0, cur)) return;
    f32x4 acc[2][2][4][2];
#pragma unroll
    for (int a = 0; a < 2; ++a)
#pragma unroll
        for (int b = 0; b < 2; ++b)
#pragma unroll
            for (int m = 0; m < 4; ++m)
#pragma unroll
                for (int n = 0; n < 2; ++n) acc[a][b][m][n] = (f32x4){0.f, 0.f, 0.f, 0.f};
    bf16x8 At[4][2], B0[2][2], B1[2][2];
    unsigned voC[2][2], voN[2][2];
    PG8_SETVO(voC, cur);
    const char* cA = cur.A; const char* cB = cur.B;
    PG8_STAGE_B(0, 0, cB); PG8_STAGE_B(0, 1, cB); PG8_STAGE_A(0, 0, cA, voC); PG8_STAGE_A(0, 1, cA, voC);
    if (wr == 1) PG8_BAR;
    PG8_WAIT_V(2); PG8_BAR;
    PG8_STAGE_B(1, 0, cB + kstep); PG8_STAGE_A(1, 0, cA + kstep, voC); PG8_STAGE_B(1, 1, cB + kstep);
    PG8_WAIT_V(6); PG8_BAR;
    for (;;) {
        const bool has_next = S.next(ui + 1, nxt);
        const char* nA = has_next ? nxt.A : cA; const char* nB = has_next ? nxt.B : cB;
        if constexpr (GATHER) { if (has_next) { PG8_SETVO(voN, nxt); } else {
#pragma unroll
            for (int _h = 0; _h < 2; ++_h)
#pragma unroll
                for (int _i = 0; _i < 2; ++_i) voN[_h][_i] = voC[_h][_i]; } }
        for (int t = 0; t < nt; t += 2) {
            const bool last = (t == nt - 2);
            const char* a1 = cA + (size_t)(t + 1) * kstep;
            const char* a2 = last ? nA : cA + (size_t)(t + 2) * kstep; const char* b2 = last ? nB : cB + (size_t)(t + 2) * kstep;
            const char* a3 = a2 + kstep; const char* b3 = b2 + kstep;
            unsigned vo2[2][2];
#pragma unroll
            for (int _h = 0; _h < 2; ++_h)
#pragma unroll
                for (int _i = 0; _i < 2; ++_i) { if constexpr (GATHER) vo2[_h][_i] = last ? voN[_h][_i] : voC[_h][_i]; else vo2[_h][_i] = voC[_h][_i]; }
            PG8_LDB(B0, 0, 0); PG8_LDB(B1, 0, 1); PG8_SCHED; PG8_LDA(At, 0, 0); PG8_STAGE_A(1, 1, a1, voC);
            PG8_WAIT_V(8); PG8_WAIT_L(0); PG8_BAR; PG8_MMA(0, 0, At, B0); PG8_MMA(0, 1, At, B1); PG8_BAR; PG8_SCHED;
            PG8_LDA(At, 0, 1); PG8_STAGE_B(0, 0, b2); PG8_STAGE_B(0, 1, b2); PG8_STAGE_A(0, 0, a2, vo2);
            PG8_WAIT_V(8); PG8_WAIT_L(0); PG8_BAR; PG8_MMA(1, 0, At, B0); PG8_MMA(1, 1, At, B1); PG8_BAR; PG8_SCHED;
            PG8_LDB(B0, 1, 0); PG8_LDB(B1, 1, 1); PG8_SCHED; PG8_LDA(At, 1, 0); PG8_STAGE_A(0, 1, a2, vo2);
            PG8_WAIT_V(8); PG8_WAIT_L(0); PG8_BAR; PG8_MMA(0, 0, At, B0); PG8_MMA(0, 1, At, B1); PG8_BAR; PG8_SCHED;
            PG8_LDA(At, 1, 1); PG8_STAGE_B(1, 0, b3); PG8_STAGE_B(1, 1, b3); PG8_STAGE_A(1, 0, a3, vo2);
            PG8_WAIT_V(8); PG8_WAIT_L(0); PG8_BAR; PG8_MMA(1, 0, At, B0); PG8_MMA(1, 1, At, B1); PG8_BAR; PG8_SCHED;
        }
        if (wr == 0) PG8_BAR;
        E(acc, cur, wr, wc, fr, fq);
        if (!has_next) break;
        if (!(Epi::CHAIN && cur.kind == 0)) {
#pragma unroll
        for (int a = 0; a < 2; ++a)
#pragma unroll
            for (int b = 0; b < 2; ++b)
#pragma unroll
                for (int m = 0; m < 4; ++m)
#pragma unroll
                    for (int n = 0; n < 2; ++n) acc[a][b][m][n] = (f32x4){0.f, 0.f, 0.f, 0.f};
        }
        cur = nxt; cA = nA; cB = nB; ++ui;
        if constexpr (GATHER) {
#pragma unroll
            for (int _h = 0; _h < 2; ++_h)
#pragma unroll
                for (int _i = 0; _i < 2; ++_i) voC[_h][_i] = voN[_h][_i]; }
        if (wr == 1) PG8_BAR;
    }
    PG8_WAIT_V(0);
    PG8_BAR;
#undef PG8_SA
#undef PG8_SB
#undef PG8_STAGE_A
#undef PG8_STAGE_B
#undef PG8_LDA
#undef PG8_LDB
#undef PG8_MMA
#undef PG8_WAIT_V
#undef PG8_WAIT_L
#undef PG8_BAR
#undef PG8_SCHED
#undef PG8_SETVO
}
}

#ifndef PROBE_FROM
#define MIDSTAMP(F, k) do { } while (0)
#else
#define MIDSTAMP(F, k) do { __syncthreads(); if (blockIdx.x == 0 && (F).tid == 0) { const unsigned long long t_ = __builtin_amdgcn_s_memrealtime(); (F).MISC[32 + 2 * (k)] = (unsigned)t_; (F).MISC[33 + 2 * (k)] = (unsigned)(t_ >> 32); } } while (0)
#endif
struct Frame {
    LAS unsigned char* lds;
    volatile LAS unsigned* MISC;
    unsigned* ctl;
    unsigned char* ws;
    int tid, lane, wave, vcu, G;
    const float *x, *c, *w_ada, *b_ada, *norm1_w, *norm2_w, *final_w, *w_in, *sg_ln_w, *sg_ln_b, *w_spatial, *b_spatial, *rel_bias, *w_out_sg, *w_out_att, *w_o, *w_rg, *w_re, *w_eg, *w_eu, *w_ed;
    float* out;
};

struct TrItem { const float* W; bf16* WT; int ldw, ldt, k0, n0, out_row0; };
__device__ __forceinline__ void transpose_load(const TrItem& t, float (&tv)[32], int lane) {
#pragma unroll
    for (int i = 0; i < 32; ++i) { const int kk = 2 * i + (lane >> 5); tv[i] = t.W[(size_t)(t.k0 + kk) * t.ldw + t.n0 + (lane & 31)]; }
}
__device__ __forceinline__ void transpose_store(const TrItem& t, const float (&tv)[32], LAS float* scr, int lane) {
#pragma unroll
    for (int i = 0; i < 32; ++i) { const int kk = 2 * i + (lane >> 5); scr[kk * 33 + (lane & 31)] = tv[i]; }
    LDS_WAIT(); asm volatile("" ::: "memory");
    const int c = lane & 7;
#pragma unroll
    for (int j = 0; j < 4; ++j) { const int n = (lane >> 3) + 8 * j; const LAS float* s = scr + (8 * c) * 33 + n;
        u32x4 o; o.x = cvt_pk_bf16(s[0 * 33], s[1 * 33]); o.y = cvt_pk_bf16(s[2 * 33], s[3 * 33]); o.z = cvt_pk_bf16(s[4 * 33], s[5 * 33]); o.w = cvt_pk_bf16(s[6 * 33], s[7 * 33]);
        *(u32x4*)(t.WT + (size_t)(t.out_row0 + n) * t.ldt + t.k0 + 8 * c) = o; }
    LDS_WAIT(); asm volatile("" ::: "memory");
}
#define TRANSPOSE_LOOP(first, stride, n, ITEM) do { int it_ = (first); if (it_ < (n)) { TrItem cur_; ITEM(it_, cur_); float tva_[32]; transpose_load(cur_, tva_, F.lane); \
    for (;;) { const int nx_ = it_ + (stride); TrItem nxt_ = cur_; float tvb_[32]; const bool hn_ = nx_ < (n); if (hn_) { ITEM(nx_, nxt_); transpose_load(nxt_, tvb_, F.lane); } \
        transpose_store(cur_, tva_, scr, F.lane); if (!hn_) break; cur_ = nxt_; it_ = nx_; _Pragma("unroll") for (int q_ = 0; q_ < 32; ++q_) tva_[q_] = tvb_[q_]; } } } while (0)

__device__ __forceinline__ void p0_prologue(Frame& F) {
    LAS float* scr = (LAS float*)(F.lds + F.wave * 16384);
    const int gw = F.vcu * NWAVES + F.wave, NGW = F.G * NWAVES;
    bf16* WINT = (bf16*)(F.ws + WS_WINT); bf16* WOSGT = (bf16*)(F.ws + WS_WOSGT); bf16* WOATTT = (bf16*)(F.ws + WS_WOATTT); bf16* WOT = (bf16*)(F.ws + WS_WOT);
    constexpr int I_IN = (DM / 64) * (INCOLS / 32), I_SG = (DSG / 64) * (DM / 32), I_O = (DM / 64) * (DM / 32);
    constexpr int NITEMS = I_IN + 2 * I_SG + I_O;
#define P0_ITEM(it, T) do { int r = (it); \
        if (r < I_IN) { const int nb = INCOLS / 32; T = TrItem{F.w_in, WINT, INCOLS, DM, 64 * (r / nb), 32 * (r % nb), 32 * (r % nb)}; } \
        else if ((r -= I_IN) < I_SG) { const int nb = DM / 32; T = TrItem{F.w_out_sg, WOSGT, DM, DSG, 64 * (r / nb), 32 * (r % nb), 32 * (r % nb)}; } \
        else if ((r -= I_SG) < I_SG) { const int nb = DM / 32; T = TrItem{F.w_out_att, WOATTT, DM, DATT, 64 * (r / nb), 32 * (r % nb), 32 * (r % nb)}; } \
        else { r -= I_SG; const int nb = DM / 32; T = TrItem{F.w_o, WOT, DM, DM, 64 * (r / nb), 32 * (r % nb), 32 * (r % nb)}; } } while (0)
    TRANSPOSE_LOOP(gw, NGW, NITEMS, P0_ITEM);
#undef P0_ITEM
    MIDSTAMP(F, 13);
    __syncthreads();
    {
        float* modp = (float*)(F.ws + WS_MODP);
        LAS float* sl = (LAS float*)F.lds;
        LAS float* red = (LAS float*)(F.lds + 4096);
        for (int v = F.vcu; v < 256; v += F.G) {
            const int sb = v >> 5, cblk = v & 31;
            { const int k = F.tid & 255, b = F.tid >> 8; const float cv = F.c[b * DM + sb * 256 + k]; sl[k * 2 + b] = cv * sigmoid_f(cv); }
            __syncthreads();
            const int kq = F.tid / 96, c4 = F.tid % 96;
            f32x4 a0 = {0.f, 0.f, 0.f, 0.f}, a1 = {0.f, 0.f, 0.f, 0.f};
            if (F.tid < 480) {
                const float* wp = F.w_ada + (size_t)(sb * 256) * (6 * DM) + cblk * 384 + c4 * 4;
#pragma unroll 13
                for (int k = kq; k < 256; k += 5) { const f32x4 w = *(const f32x4*)(wp + (size_t)k * (6 * DM)); const f32x2 sv = *(const LAS f32x2*)(sl + k * 2); a0 += w * sv.x; a1 += w * sv.y; }
                *(LAS f32x4*)(red + (kq * 96 + c4) * 8) = a0; *(LAS f32x4*)(red + (kq * 96 + c4) * 8 + 4) = a1;
            }
            __syncthreads();
            if (F.tid < 192) { const int b = F.tid / 96, cc = F.tid % 96; f32x4 sum = {0.f, 0.f, 0.f, 0.f};
#pragma unroll
                for (int q = 0; q < 5; ++q) sum += *(const LAS f32x4*)(red + (q * 96 + cc) * 8 + b * 4);
                *(f32x4*)(modp + ((size_t)(sb * 2 + b)) * (6 * DM) + cblk * 384 + cc * 4) = sum; }
            __syncthreads();
        }
    }
}

__device__ __forceinline__ f32x4 mod4(const float* modp, const float* b_ada, int b, int col) {
    f32x4 s = *(const f32x4*)(b_ada + col);
#pragma unroll
    for (int q = 0; q < 8; ++q) s += *(const f32x4*)(modp + ((size_t)(q * 2 + b)) * (6 * DM) + col);
    return s;
}
__device__ __forceinline__ float mod1(const float* modp, const float* b_ada, int b, int col) {
    float s = b_ada[col];
#pragma unroll
    for (int q = 0; q < 8; ++q) s += modp[((size_t)(q * 2 + b)) * (6 * DM) + col];
    return s;
}

__device__ __forceinline__ void p1_norm1(Frame& F) {
    const int gw = F.vcu * NWAVES + F.wave, NGW = F.G * NWAVES;
    const float* modp = (const float*)(F.ws + WS_MODP);
    bf16* H = (bf16*)(F.ws + WS_H);
    { float* modw = (float*)(F.ws + WS_MOD);
      for (int v = F.vcu; v < 256; v += F.G) if (F.tid < 96) { const int b = F.tid / 48, col = v * 48 + F.tid % 48; modw[b * (6 * DM) + col] = mod1(modp, F.b_ada, b, col); } }
    LAS float* avs = (LAS float*)F.lds; LAS float* svs = avs + BATCH * DM;
#pragma unroll
    for (int i = 0; i < 4; ++i) { const int idx = F.tid + NTHR * i, which = idx >> 9, col = 4 * (idx & 511), b = which >> 1;
        const f32x4 v = mod4(modp, F.b_ada, b, (which & 1) * DM + col);
        if (which & 1) *(LAS f32x4*)(avs + b * DM + col) = *(const f32x4*)(F.norm1_w + col) * (v + 1.0f); else *(LAS f32x4*)(svs + b * DM + col) = v; }
    __syncthreads();
    int curb = -1; f32x4 av[8], sv[8];
    for (int m = gw; m < MTOK; m += 2 * NGW) {
        const int b = m / SEQ;
        if (b != curb) { curb = b;
#pragma unroll
            for (int j = 0; j < 8; ++j) { const int col = 4 * F.lane + 256 * j;
                av[j] = *(const LAS f32x4*)(avs + b * DM + col); sv[j] = *(const LAS f32x4*)(svs + b * DM + col); } }
        const f32x4* xr0 = (const f32x4*)(F.x + (size_t)m * DM) + F.lane; const f32x4* xr1 = (const f32x4*)(F.x + (size_t)(m + NGW) * DM) + F.lane;
        f32x4 v0[8], v1[8]; float s0 = 0.f, s1 = 0.f;
#pragma unroll
        for (int j = 0; j < 8; ++j) { v0[j] = xr0[64 * j]; v1[j] = xr1[64 * j]; }
#pragma unroll
        for (int j = 0; j < 8; ++j) { s0 += (v0[j].x * v0[j].x + v0[j].y * v0[j].y) + (v0[j].z * v0[j].z + v0[j].w * v0[j].w); s1 += (v1[j].x * v1[j].x + v1[j].y * v1[j].y) + (v1[j].z * v1[j].z + v1[j].w * v1[j].w); }
        const float r0 = 1.0f / sqrtf(wave_sum(s0) * (1.0f / DM) + EPS), r1 = 1.0f / sqrtf(wave_sum(s1) * (1.0f / DM) + EPS);
        u32x2* o0 = (u32x2*)(H + (size_t)m * DM) + F.lane; u32x2* o1 = (u32x2*)(H + (size_t)(m + NGW) * DM) + F.lane;
#pragma unroll
        for (int j = 0; j < 8; ++j) { const f32x4 h0 = v0[j] * r0 * av[j] + sv[j], h1 = v1[j] * r1 * av[j] + sv[j];
            u32x2 w0, w1; w0.x = cvt_pk_bf16(h0.x, h0.y); w0.y = cvt_pk_bf16(h0.z, h0.w); w1.x = cvt_pk_bf16(h1.x, h1.y); w1.y = cvt_pk_bf16(h1.z, h1.w); o0[64 * j] = w0; o1[64 * j] = w1; }
    }
    float* A2 = (float*)(F.ws + WS_A2); bf16* WR = (bf16*)(F.ws + WS_WR);
    for (int idx = F.vcu * NTHR + F.tid; idx < BATCH * 32 * DM; idx += F.G * NTHR) {
        const int k = idx % DM, col = (idx / DM) % 32, b = idx / (32 * DM);
        const float a2 = F.norm2_w[k] * (1.0f + mod1(modp, F.b_ada, b, 4 * DM + k));
        if (col == 0) A2[b * DM + k] = a2;
        const float w = col < 4 ? F.w_rg[k * 4 + col] : (col < 20 ? F.w_re[k * 16 + (col - 4)] : 0.f);
        const float v = a2 * w;
        const unsigned hi = cvt_pk_bf16(v, 0.f) & 0xffffu; const float lo = v - bf_lo(hi);
        WR[((size_t)(b * 2 + 0) * 32 + col) * DM + k] = (bf16)hi;
        WR[((size_t)(b * 2 + 1) * 32 + col) * DM + k] = (bf16)(cvt_pk_bf16(lo, 0.f) & 0xffffu);
    }
}

struct SchedGrid {
    const char* A; const char* B; int nN, nwg, G, c; size_t a_tstep, b_tstep;
    __device__ __forceinline__ bool next(int i, pg8::Unit& u) const {
        const int L = i * G + c; if (L >= nwg) return false;
        const int nig = 8 * nN, gid = L / nig, rem = L % nig;
        u.pm = gid * 8 + (rem & 7); u.pn = rem >> 3; u.kind = 0; u.aux = 0;
        u.A = A + (size_t)u.pm * a_tstep; u.B = B + (size_t)u.pn * b_tstep; return true;
    }
    __device__ __forceinline__ int row_of(const pg8::Unit&, int) const { return 0; }
};

struct EpiProj {
    static constexpr bool CHAIN = false;
    unsigned char* ws; float* ksum;
    __device__ __forceinline__ void operator()(f32x4 (&acc)[2][2][4][2], const pg8::Unit& u, int wr, int wc, int fr, int fq) const {
        const int pn = u.pn; int act, ld, colt; bf16* base;
        if (pn < 20) { const int t = pn >> 2; base = (bf16*)(ws + WS_U + (size_t)t * (32 * MiB)); ld = 1024; colt = (pn & 3) * 256; act = (t < 2) ? 1 : 0; }
        else { const int t = (pn - 20) >> 3; base = (bf16*)(ws + WS_GS + (size_t)t * (64 * MiB)); ld = 2048; colt = ((pn - 20) & 7) * 256; act = 2; }
        const int row0 = u.pm * 256 + wr * 64 + fr, col0 = colt + wc * 32 + 8 * fq;
        if (pn >= 12 && pn < 16) {
            const int b = u.pm >> 5, blk = u.pm & 31;
#pragma unroll
            for (int bj = 0; bj < 2; ++bj)
#pragma unroll
                for (int n = 0; n < 2; ++n) {
                    f32x4 s = {0.f, 0.f, 0.f, 0.f};
#pragma unroll
                    for (int ai = 0; ai < 2; ++ai)
#pragma unroll
                        for (int m = 0; m < 4; ++m) s += acc[ai][bj][m][n];
#pragma unroll
                    for (int o = 1; o < 16; o <<= 1) { s.x += __shfl_xor(s.x, o); s.y += __shfl_xor(s.y, o); s.z += __shfl_xor(s.z, o); s.w += __shfl_xor(s.w, o); }
                    if (fr == 0) { float* dst = ksum + (((b * 8 + (pn - 12) * 2 + bj) * 32 + blk) * 128 + wc * 32 + 8 * fq + 4 * n);
                        atomicAdd(dst + 0, s.x); atomicAdd(dst + 1, s.y); atomicAdd(dst + 2, s.z); atomicAdd(dst + 3, s.w); }
                }
        }
#pragma unroll
        for (int ai = 0; ai < 2; ++ai)
#pragma unroll
            for (int m = 0; m < 4; ++m) { bf16* rowp = base + (size_t)(row0 + ai * 128 + m * 16) * ld + col0;
#pragma unroll
                for (int bj = 0; bj < 2; ++bj) { f32x4 v0 = acc[ai][bj][m][0], v1 = acc[ai][bj][m][1];
                    if (act == 1) { const f32x2 a = gelu_pk((f32x2){v0[0], v0[1]}), b = gelu_pk((f32x2){v0[2], v0[3]}), c = gelu_pk((f32x2){v1[0], v1[1]}), d = gelu_pk((f32x2){v1[2], v1[3]});
                        v0 = (f32x4){a.x, a.y, b.x, b.y}; v1 = (f32x4){c.x, c.y, d.x, d.y}; }
                    else if (act == 2) {
#pragma unroll
                        for (int j = 0; j < 4; ++j) { v0[j] = sigmoid_f(v0[j]); v1[j] = sigmoid_f(v1[j]); } }
                    u32x4 w; w.x = cvt_pk_bf16(v0[0], v0[1]); w.y = cvt_pk_bf16(v0[2], v0[3]); w.z = cvt_pk_bf16(v1[0], v1[1]); w.w = cvt_pk_bf16(v1[2], v1[3]);
                    *(u32x4*)(rowp + bj * 128) = w; } }
    }
};

struct SchedPair {
    const char *A0, *A1, *B0, *B1; int G, c;
    __device__ __forceinline__ bool next(int i, pg8::Unit& u) const {
        const int L = (i >> 1) * G + c; if (L >= 512) return false;
        const int part = i & 1, gid = L >> 6, rem = L & 63;
        u.pm = gid * 8 + (rem & 7); u.pn = rem >> 3; u.kind = part; u.aux = 0;
        u.A = (part ? A1 : A0) + (size_t)u.pm * (256 * 1024 * 2); u.B = (part ? B1 : B0) + (size_t)u.pn * (256 * 1024 * 2); return true;
    }
    __device__ __forceinline__ int row_of(const pg8::Unit&, int) const { return 0; }
};
struct EpiMerge {
    static constexpr bool CHAIN = true;
    const bf16 *GS, *GA; bf16* MERGED;
    __device__ __forceinline__ void operator()(f32x4 (&acc)[2][2][4][2], const pg8::Unit& u, int wr, int wc, int fr, int fq) const {
        const int row0 = u.pm * 256 + wr * 64 + fr, col0 = u.pn * 256 + wc * 32 + 8 * fq;
#define EM_SEQ() do { EM_LOAD(0, 0); asm volatile("" ::: "memory"); \
        EM_LOAD(1, 1); EM_COMP(0, 0); asm volatile("" ::: "memory"); EM_LOAD(2, 0); EM_COMP(1, 1); asm volatile("" ::: "memory"); \
        EM_LOAD(3, 1); EM_COMP(2, 0); asm volatile("" ::: "memory"); EM_LOAD(4, 0); EM_COMP(3, 1); asm volatile("" ::: "memory"); \
        EM_LOAD(5, 1); EM_COMP(4, 0); asm volatile("" ::: "memory"); EM_LOAD(6, 0); EM_COMP(5, 1); asm volatile("" ::: "memory"); \
        EM_LOAD(7, 1); EM_COMP(6, 0); asm volatile("" ::: "memory"); EM_COMP(7, 1); } while (0)
        if (u.kind == 0) {
            u32x4 ga[2][2], gs[2][2];
#define EM_LOAD(q, B) do { _Pragma("unroll") for (int bj = 0; bj < 2; ++bj) { const size_t off = (size_t)(row0 + ((q) >> 2) * 128 + ((q) & 3) * 16) * DM + col0 + bj * 128; \
                ga[B][bj] = *(const u32x4*)(GA + off); gs[B][bj] = *(const u32x4*)(GS + off); } } while (0)
#define EM_COMP(q, B) do { _Pragma("unroll") for (int bj = 0; bj < 2; ++bj) { const int ai = (q) >> 2, m = (q) & 3; const u32x4 a = ga[B][bj], g = gs[B][bj]; \
                const f32x4 a0 = {bf_lo(a.x), bf_hi(a.x), bf_lo(a.y), bf_hi(a.y)}, a1 = {bf_lo(a.z), bf_hi(a.z), bf_lo(a.w), bf_hi(a.w)}; \
                const f32x4 s0 = {bf_lo(g.x), bf_hi(g.x), bf_lo(g.y), bf_hi(g.y)}, s1 = {bf_lo(g.z), bf_hi(g.z), bf_lo(g.w), bf_hi(g.w)}; \
                _Pragma("unroll") for (int j = 0; j < 4; ++j) { acc[ai][bj][m][0][j] *= s0[j] * __builtin_amdgcn_rcpf(a0[j]); acc[ai][bj][m][1][j] *= s1[j] * __builtin_amdgcn_rcpf(a1[j]); } } } while (0)
            EM_SEQ();
#undef EM_LOAD
#undef EM_COMP
        } else {
            u32x4 ga[2][2];
#define EM_LOAD(q, B) do { _Pragma("unroll") for (int bj = 0; bj < 2; ++bj) ga[B][bj] = *(const u32x4*)(GA + (size_t)(row0 + ((q) >> 2) * 128 + ((q) & 3) * 16) * DM + col0 + bj * 128); } while (0)
#define EM_COMP(q, B) do { _Pragma("unroll") for (int bj = 0; bj < 2; ++bj) { const int ai = (q) >> 2, m = (q) & 3; const u32x4 a = ga[B][bj]; \
                const f32x4 a0 = {bf_lo(a.x), bf_hi(a.x), bf_lo(a.y), bf_hi(a.y)}, a1 = {bf_lo(a.z), bf_hi(a.z), bf_lo(a.w), bf_hi(a.w)}; \
                const f32x4 v0 = acc[ai][bj][m][0] * a0, v1 = acc[ai][bj][m][1] * a1; \
                u32x4 w; w.x = cvt_pk_bf16(v0[0], v0[1]); w.y = cvt_pk_bf16(v0[2], v0[3]); w.z = cvt_pk_bf16(v1[0], v1[1]); w.w = cvt_pk_bf16(v1[2], v1[3]); \
                *(u32x4*)(MERGED + (size_t)(row0 + ai * 128 + m * 16) * DM + col0 + bj * 128) = w; } } while (0)
            EM_SEQ();
#undef EM_LOAD
#undef EM_COMP
        }
#undef EM_SEQ
    }
};

struct EpiX1 {
    static constexpr bool CHAIN = false;
    const float* x; const float* mod; float* out; float* ssq;
    __device__ __forceinline__ void operator()(f32x4 (&acc)[2][2][4][2], const pg8::Unit& u, int wr, int wc, int fr, int fq) const {
        const int row0 = u.pm * 256 + wr * 64 + fr, col0 = u.pn * 256 + wc * 32 + 4 * fq;
        const float* g1 = mod + (u.pm >> 5) * (6 * DM) + 2 * DM + col0;
        f32x4 gv[2][2];
#pragma unroll
        for (int bj = 0; bj < 2; ++bj)
#pragma unroll
            for (int n = 0; n < 2; ++n) gv[bj][n] = *(const f32x4*)(g1 + bj * 128 + n * 16);
        f32x4 xv[2][2][2];
#define EX_LOAD(q, B) do { _Pragma("unroll") for (int bj = 0; bj < 2; ++bj) _Pragma("unroll") for (int n = 0; n < 2; ++n) \
            xv[B][bj][n] = *(const f32x4*)(x + (size_t)(row0 + ((q) >> 2) * 128 + ((q) & 3) * 16) * DM + col0 + bj * 128 + n * 16); } while (0)
#define EX_COMP(q, B) do { const int ai = (q) >> 2, m = (q) & 3; const int row = row0 + ai * 128 + m * 16; const size_t off = (size_t)row * DM + col0; float s = 0.f; \
            _Pragma("unroll") for (int bj = 0; bj < 2; ++bj) _Pragma("unroll") for (int n = 0; n < 2; ++n) { const f32x4 o = xv[B][bj][n] + gv[bj][n] * acc[ai][bj][m][n]; \
                *(f32x4*)(out + off + bj * 128 + n * 16) = o; s += (o.x * o.x + o.y * o.y) + (o.z * o.z + o.w * o.w); } \
            s += __shfl_xor(s, 16); s += __shfl_xor(s, 32); if (fq == 0) ssq[(size_t)row * 32 + u.pn * 4 + wc] = s; } while (0)
        EX_LOAD(0, 0); asm volatile("" ::: "memory");
        EX_LOAD(1, 1); EX_COMP(0, 0); asm volatile("" ::: "memory");
        EX_LOAD(2, 0); EX_COMP(1, 1); asm volatile("" ::: "memory");
        EX_LOAD(3, 1); EX_COMP(2, 0); asm volatile("" ::: "memory");
        EX_LOAD(4, 0); EX_COMP(3, 1); asm volatile("" ::: "memory");
        EX_LOAD(5, 1); EX_COMP(4, 0); asm volatile("" ::: "memory");
        EX_LOAD(6, 0); EX_COMP(5, 1); asm volatile("" ::: "memory");
        EX_LOAD(7, 1); EX_COMP(6, 0); asm volatile("" ::: "memory");
        EX_COMP(7, 1);
#undef EX_LOAD
#undef EX_COMP
    }
};

struct SchedMoe {
    const unsigned* slottok; const char* A; const char* B; const LAS int* tab; int G, c, shift; size_t b_estep, b_tstep, a_tstep;
    __device__ __forceinline__ bool next(int i, pg8::Unit& u) const {
        const int L = i * G + c; if (L >= (tab[16] << shift)) return false;
        const int tile = L >> shift; u.pn = L & ((1 << shift) - 1); int e = 0; while (tab[e + 1] <= tile) ++e;
        u.pm = tile; u.kind = e; u.aux = tile - tab[e];
        u.A = A + (size_t)tile * a_tstep; u.B = B + (size_t)e * b_estep + (size_t)u.pn * b_tstep; return true;
    }
    __device__ __forceinline__ int row_of(const pg8::Unit& u, int r) const { const int sl = u.aux * 256 + r; return sl < tab[32 + u.kind] ? (int)(slottok[u.kind * 16384 + sl] & 0xffffu) : 0; }
};
struct EpiSwiglu {
    static constexpr bool CHAIN = false;
    bf16* ACT;
    __device__ __forceinline__ void operator()(f32x4 (&acc)[2][2][4][2], const pg8::Unit& u, int wr, int wc, int fr, int fq) const {
        const int row0 = u.pm * 256 + wr * 64 + fr, col0 = u.pn * 128 + wc * 32 + 8 * fq;
#pragma unroll
        for (int ai = 0; ai < 2; ++ai)
#pragma unroll
            for (int m = 0; m < 4; ++m) { f32x4 v0, v1;
#pragma unroll
                for (int j = 0; j < 4; ++j) { const float g0 = acc[ai][0][m][0][j], g1 = acc[ai][0][m][1][j];
                    v0[j] = g0 * sigmoid_f(g0) * acc[ai][1][m][0][j]; v1[j] = g1 * sigmoid_f(g1) * acc[ai][1][m][1][j]; }
                u32x4 w; w.x = cvt_pk_bf16(v0[0], v0[1]); w.y = cvt_pk_bf16(v0[2], v0[3]); w.z = cvt_pk_bf16(v1[0], v1[1]); w.w = cvt_pk_bf16(v1[2], v1[3]);
                *(u32x4*)(ACT + (size_t)(row0 + ai * 128 + m * 16) * DE + col0) = w; }
    }
};
struct EpiDown {
    static constexpr bool CHAIN = false;
    const unsigned* slottok; const float* slotw; const LAS int* tab; bf16 *O0, *O1;
    __device__ __forceinline__ void operator()(f32x4 (&acc)[2][2][4][2], const pg8::Unit& u, int wr, int wc, int fr, int fq) const {
        const int e = u.kind, cnt = tab[32 + e], col0 = u.pn * 256 + wc * 32 + 8 * fq;
        unsigned info[2][4]; float wt[2][4];
#pragma unroll
        for (int ai = 0; ai < 2; ++ai)
#pragma unroll
            for (int m = 0; m < 4; ++m) { const int sl = u.aux * 256 + ai * 128 + wr * 64 + m * 16 + fr; const bool ok = sl < cnt;
                info[ai][m] = ok ? slottok[e * 16384 + sl] : 0xffffffffu; wt[ai][m] = ok ? slotw[e * 16384 + sl] : 0.f; }
#pragma unroll
        for (int ai = 0; ai < 2; ++ai)
#pragma unroll
            for (int m = 0; m < 4; ++m) {
                if (info[ai][m] != 0xffffffffu) { const float w = wt[ai][m];
                    bf16* dst = ((info[ai][m] >> 16) ? O1 : O0) + (size_t)(info[ai][m] & 0xffffu) * DM + col0;
#pragma unroll
                    for (int bj = 0; bj < 2; ++bj) { const f32x4 v0 = acc[ai][bj][m][0] * w, v1 = acc[ai][bj][m][1] * w;
                        u32x4 o; o.x = cvt_pk_bf16(v0[0], v0[1]); o.y = cvt_pk_bf16(v0[2], v0[3]); o.z = cvt_pk_bf16(v1[0], v1[1]); o.w = cvt_pk_bf16(v1[2], v1[3]);
                        *(u32x4*)(dst + bj * 128) = o; } } }
    }
};

__device__ __forceinline__ int list_base(int b, int h, int j) { return (b * 8 + h) * LIST_PER_BH + 256 * (32 * j - (j * (j - 1)) / 2); }

__device__ __forceinline__ void sgu_unit(Frame& F, int b, int c, int half) {
    LAS float* st = (LAS float*)F.lds;
    LAS bf16* vnT = (LAS bf16*)(F.lds + 1024);
    const int r0 = b * SEQ + c * 128;
    const bf16* VG = (const bf16*)(F.ws + WS_VG); const bf16* U = (const bf16*)(F.ws + WS_U); bf16* YSG = (bf16*)(F.ws + WS_YSG);
    { u32x4 ra[16], rq[16];
#pragma unroll
      for (int rr = 0; rr < 16; ++rr) { const u32x4* p = (const u32x4*)(VG + (size_t)(r0 + F.wave * 16 + rr) * DSG) + F.lane * 2; ra[rr] = p[0]; rq[rr] = p[1]; }
#pragma unroll
      for (int rr = 0; rr < 16; ++rr) { const int row = F.wave * 16 + rr; float s = 0.f, ss = 0.f;
        const unsigned wv[8] = {ra[rr].x, ra[rr].y, ra[rr].z, ra[rr].w, rq[rr].x, rq[rr].y, rq[rr].z, rq[rr].w};
#pragma unroll
        for (int e = 0; e < 8; ++e) { const float lo = bf_lo(wv[e]), hi = bf_hi(wv[e]); s += lo + hi; ss += lo * lo + hi * hi; }
        s = wave_sum(s); ss = wave_sum(ss);
        const float mean = s * (1.0f / DSG), var = fmaxf(ss * (1.0f / DSG) - mean * mean, 0.f);
        if (F.lane == 0) { st[row * 2] = mean; st[row * 2 + 1] = 1.0f / sqrtf(var + EPS); } } }
    __syncthreads();
    for (int gi = 0; gi < 4; ++gi) { const int g = half * 4 + gi;
        { const int s = F.tid >> 2, dq = F.tid & 3; const float mean = st[s * 2], rstd = st[s * 2 + 1];
          const bf16* src = VG + (size_t)(r0 + s) * DSG + g * 128 + dq * 32;
#pragma unroll
          for (int v4 = 0; v4 < 4; ++v4) { const u32x4 w = *(const u32x4*)(src + v4 * 8); const unsigned wv[4] = {w.x, w.y, w.z, w.w};
              const int colb = g * 128 + dq * 32 + v4 * 8;
              const f32x4 lw0 = *(const f32x4*)(F.sg_ln_w + colb), lw1 = *(const f32x4*)(F.sg_ln_w + colb + 4), lb0 = *(const f32x4*)(F.sg_ln_b + colb), lb1 = *(const f32x4*)(F.sg_ln_b + colb + 4);
              const float lw[8] = {lw0.x, lw0.y, lw0.z, lw0.w, lw1.x, lw1.y, lw1.z, lw1.w}, lb[8] = {lb0.x, lb0.y, lb0.z, lb0.w, lb1.x, lb1.y, lb1.z, lb1.w};
#pragma unroll
              for (int e = 0; e < 4; ++e) { const float x0 = bf_lo(wv[e]), x1 = bf_hi(wv[e]);
                  const float n0 = (x0 - mean) * rstd * lw[2 * e] + lb[2 * e], n1 = (x1 - mean) * rstd * lw[2 * e + 1] + lb[2 * e + 1];
                  const unsigned pk = cvt_pk_bf16(n0, n1);
                  vnT[(dq * 32 + v4 * 8 + 2 * e) * 136 + s] = (bf16)(pk & 0xffffu); vnT[(dq * 32 + v4 * 8 + 2 * e + 1) * 136 + s] = (bf16)(pk >> 16); } } }
        __syncthreads();
        { const int t0 = F.wave * 16, cl = F.lane & 15, g4 = F.lane >> 4, t = t0 + cl, nks = (t0 + 15) / 32 + 1;
          bf16x8 wf[4];
#pragma unroll
          for (int ks = 0; ks < 4; ++ks) { u32x4 pk = {0u, 0u, 0u, 0u};
              if (ks < nks) { const int s0 = ks * 32 + 8 * g4; const float* wp = F.w_spatial + ((size_t)(g * 128 + t)) * 128 + s0;
                  const f32x4 w0 = *(const f32x4*)wp, w1 = *(const f32x4*)(wp + 4);
                  float wv[8] = {w0.x, w0.y, w0.z, w0.w, w1.x, w1.y, w1.z, w1.w};
#pragma unroll
                  for (int jj = 0; jj < 8; ++jj) wv[jj] = (s0 + jj <= t) ? wv[jj] : 0.f;
                  pk.x = cvt_pk_bf16(wv[0], wv[1]); pk.y = cvt_pk_bf16(wv[2], wv[3]); pk.z = cvt_pk_bf16(wv[4], wv[5]); pk.w = cvt_pk_bf16(wv[6], wv[7]); }
              wf[ks] = __builtin_bit_cast(bf16x8, pk); }
          const float bias = F.b_spatial[g * 128 + t];
          u32x2 uu8[8];
#pragma unroll
          for (int db = 0; db < 8; ++db) uu8[db] = *(const u32x2*)(U + (size_t)(r0 + t) * DSG + g * 128 + db * 16 + 4 * g4);
#pragma unroll
          for (int db = 0; db < 8; ++db) { f32x4 acc = {0.f, 0.f, 0.f, 0.f};
#pragma unroll
              for (int ks = 0; ks < 4; ++ks) if (ks < nks) { const bf16x8 a = *(const LAS bf16x8*)(vnT + (db * 16 + cl) * 136 + ks * 32 + 8 * g4); acc = __builtin_amdgcn_mfma_f32_16x16x32_bf16(a, wf[ks], acc, 0, 0, 0); }
              const size_t off = (size_t)(r0 + t) * DSG + g * 128 + db * 16 + 4 * g4;
              const u32x2 uu = uu8[db];
              u32x2 o; o.x = cvt_pk_bf16(bf_lo(uu.x) * (acc[0] + bias), bf_hi(uu.x) * (acc[1] + bias)); o.y = cvt_pk_bf16(bf_lo(uu.y) * (acc[2] + bias), bf_hi(uu.y) * (acc[3] + bias));
              *(u32x2*)(YSG + off) = o; } }
        __syncthreads();
    }
}

__device__ __forceinline__ void select_unit(Frame& F, int b, int h, int i) {
    LAS float* ks = (LAS float*)F.lds;
    LAS int* lcnt = (LAS int*)(F.lds + 17408); LAS int* gbase = lcnt + 32;
    const float* ksum = (const float*)(F.ctl + CW_KSUM) + (size_t)(b * 8 + h) * 32 * 128;
    unsigned* acnt = F.ctl + CW_ACNT + (b * 8 + h) * 32;
    unsigned* lists = (unsigned*)(F.ws + WS_LISTS); f32x2* ML = (f32x2*)(F.ws + WS_ML);
    for (int idx = F.tid; idx < 32 * 128; idx += NTHR) { const int j = idx >> 7; ks[j * 132 + (idx & 127)] = j < i ? ksum[idx] : 0.f; }
    if (F.tid < 32) lcnt[F.tid] = 0;
    __syncthreads();
    const int r32 = F.lane & 31, hi = F.lane >> 5, q = F.wave * 32 + r32, s = i * 256 + q;
    const bf16* Qw = (const bf16*)(F.ws + WS_Q) + (size_t)(b * SEQ + s) * DATT + h * 128 + hi * 8;
    bf16x8 qr[8];
#pragma unroll
    for (int d0 = 0; d0 < 8; ++d0) qr[d0] = *(const bf16x8*)(Qw + d0 * 16);
    f32x16 p = {};
#pragma unroll
    for (int d0 = 0; d0 < 8; ++d0) { const LAS f32x4* kp = (const LAS f32x4*)(ks + r32 * 132 + d0 * 16 + hi * 8); const f32x4 k0 = kp[0], k1 = kp[1];
        u32x4 kh; kh.x = cvt_pk_bf16(k0.x, k0.y); kh.y = cvt_pk_bf16(k0.z, k0.w); kh.z = cvt_pk_bf16(k1.x, k1.y); kh.w = cvt_pk_bf16(k1.z, k1.w);
        u32x4 kl; kl.x = cvt_pk_bf16(k0.x - bf_lo(kh.x), k0.y - bf_hi(kh.x)); kl.y = cvt_pk_bf16(k0.z - bf_lo(kh.y), k0.w - bf_hi(kh.y));
        kl.z = cvt_pk_bf16(k1.x - bf_lo(kh.z), k1.y - bf_hi(kh.z)); kl.w = cvt_pk_bf16(k1.z - bf_lo(kh.w), k1.w - bf_hi(kh.w));
        p = __builtin_amdgcn_mfma_f32_32x32x16_bf16(__builtin_bit_cast(bf16x8, kh), qr[d0], p, 0, 0, 0);
        p = __builtin_amdgcn_mfma_f32_32x32x16_bf16(__builtin_bit_cast(bf16x8, kl), qr[d0], p, 0, 0, 0); }
    float s1 = -INFINITY, s2 = -INFINITY, s3 = -INFINITY; int j1 = 64, j2 = 65, j3 = 66;
#define SEL_INS(dv, jv) do { const float d_ = (dv); const int j_ = (jv); \
        if (d_ > s1 || (d_ == s1 && j_ < j1)) { s3 = s2; j3 = j2; s2 = s1; j2 = j1; s1 = d_; j1 = j_; } \
        else if (d_ > s2 || (d_ == s2 && j_ < j2)) { s3 = s2; j3 = j2; s2 = d_; j2 = j_; } \
        else if (d_ > s3 || (d_ == s3 && j_ < j3)) { s3 = d_; j3 = j_; } } while (0)
#pragma unroll
    for (int r = 0; r < 16; ++r) { const int j = (r & 3) + 8 * (r >> 2) + 4 * hi; if (j < i) SEL_INS(p[r], j); }
    { const float t1 = __shfl_xor(s1, 32), t2 = __shfl_xor(s2, 32), t3 = __shfl_xor(s3, 32); const int u1 = __shfl_xor(j1, 32), u2 = __shfl_xor(j2, 32), u3 = __shfl_xor(j3, 32);
      if (u1 < 32) SEL_INS(t1, u1); if (u2 < 32) SEL_INS(t2, u2); if (u3 < 32) SEL_INS(t3, u3); }
#undef SEL_INS
    const int nv = i < 3 ? i : 3;
    int pos0 = 0, pos1 = 0, pos2 = 0;
    if (hi == 0) { if (nv > 0) pos0 = atomicAdd((int*)&lcnt[j1], 1); if (nv > 1) pos1 = atomicAdd((int*)&lcnt[j2], 1); if (nv > 2) pos2 = atomicAdd((int*)&lcnt[j3], 1); }
    __syncthreads();
    if (F.tid < 32) { const int n = lcnt[F.tid]; gbase[F.tid] = n > 0 ? (int)atomicAdd(acnt + F.tid, (unsigned)n) : 0; }
    __syncthreads();
    if (hi == 0) {
        const size_t mlb = ((size_t)(b * 8 + h) * SEQ + s) * 4;
        if (nv > 0) lists[list_base(b, h, j1) + 256 + gbase[j1] + pos0] = ((unsigned)s << 2) | 0u; else ML[mlb + 0] = (f32x2){-1e30f, 0.f};
        if (nv > 1) lists[list_base(b, h, j2) + 256 + gbase[j2] + pos1] = ((unsigned)s << 2) | 1u; else ML[mlb + 1] = (f32x2){-1e30f, 0.f};
        if (nv > 2) lists[list_base(b, h, j3) + 256 + gbase[j3] + pos2] = ((unsigned)s << 2) | 2u; else ML[mlb + 2] = (f32x2){-1e30f, 0.f};
        lists[list_base(b, h, i) + q] = ((unsigned)s << 2) | 3u;
    }
    __syncthreads();
}

namespace att {
constexpr int KVBLK = 64;
constexpr int SHM_V = KVBLK * HD * 2, SHM_K = KVBLK * HD * 2;
constexpr int WS_OFF = 65536, LUT_OFF = 67584, PRE_OFF = 69888, OST_OFF = 72192, OST_WAVE = 8704, OST_STRIDE = 272;
constexpr float SCALE = 0.088388347648318440f;
constexpr float C = SCALE * LOG2E;
constexpr float THR2 = 11.5f;
#define KSWZ(row, colB) ((row) * 256 + ((colB) ^ (((row) & 7) << 4)))
#define SBAR() __builtin_amdgcn_sched_barrier(0)
__device__ __forceinline__ int crow(int r, int hi) { return (r & 3) + 8 * (r >> 2) + 4 * hi; }
__device__ __forceinline__ void partialSM(f32x16& p0, f32x16& p1, float& m_reg, float& mn, float& alpha, int relb, int hi, const LAS float* lut) {
    if (__all(relb - 63 >= 128)) { const float c31 = lut[512];
#pragma unroll
        for (int r = 0; r < 16; ++r) { p0[r] = fmaf(p0[r], C, c31); p1[r] = fmaf(p1[r], C, c31); } }
    else {
#pragma unroll
        for (int r = 0; r < 16; ++r) { const int rel = relb - crow(r, hi);
            const int i0 = min(max(rel + 1, 0), 512), i1 = min(max(rel - 31, 0), 512);
            p0[r] = fmaf(p0[r], C, lut[i0]); p1[r] = fmaf(p1[r], C, lut[i1]); } }
    float pmax = p0[0];
#pragma unroll
    for (int r = 1; r < 16; ++r) pmax = fmaxf(pmax, p0[r]);
#pragma unroll
    for (int r = 0; r < 16; ++r) pmax = fmaxf(pmax, p1[r]);
    { auto rr = __builtin_amdgcn_permlane32_swap(__float_as_uint(pmax), __float_as_uint(pmax), false, false);
      pmax = fmaxf(__uint_as_float(rr[0]), __uint_as_float(rr[1])); }
    if (__builtin_expect(__all(pmax - m_reg <= THR2), 1)) { mn = m_reg; alpha = 1.f; }
    else { mn = fmaxf(m_reg, pmax); alpha = __builtin_amdgcn_exp2f(m_reg - mn); m_reg = mn; }
#pragma unroll
    for (int r = 0; r < 16; ++r) { p0[r] -= mn; p1[r] -= mn; }
#pragma unroll
    for (int r = 0; r < 16; ++r) p0[r] = __builtin_amdgcn_exp2f(p0[r]);
}
__device__ __forceinline__ void finishSM(f32x16& p0, f32x16& p1, float alpha, float& l_reg, bf16x8& pa0, bf16x8& pa1, bf16x8& pa2, bf16x8& pa3) {
#pragma unroll
    for (int r = 0; r < 16; ++r) p1[r] = __builtin_amdgcn_exp2f(p1[r]);
    float ps = 0;
#pragma unroll
    for (int r = 0; r < 16; ++r) ps += p0[r];
#pragma unroll
    for (int r = 0; r < 16; ++r) ps += p1[r];
    { auto rr = __builtin_amdgcn_permlane32_swap(__float_as_uint(ps), __float_as_uint(ps), false, false);
      ps = __uint_as_float(rr[0]) + __uint_as_float(rr[1]); }
    l_reg = l_reg * alpha + ps;
#define PK4(P, BASE, OUT) do { unsigned a0 = cvt_pk_bf16(P[BASE + 0], P[BASE + 1]), a1 = cvt_pk_bf16(P[BASE + 2], P[BASE + 3]);   \
    unsigned b0 = cvt_pk_bf16(P[BASE + 4], P[BASE + 5]), b1 = cvt_pk_bf16(P[BASE + 6], P[BASE + 7]);                              \
    auto r0 = __builtin_amdgcn_permlane32_swap(a0, b0, false, false); auto r1 = __builtin_amdgcn_permlane32_swap(a1, b1, false, false); \
    u32x4 w = {r0[0], r1[0], r0[1], r1[1]}; OUT = __builtin_bit_cast(bf16x8, w); } while (0)
    PK4(p0, 0, pa0); PK4(p0, 8, pa1); PK4(p1, 0, pa2); PK4(p1, 8, pa3);
#undef PK4
}
__device__ __forceinline__ void qkt(f32x16& p0, f32x16& p1, const LAS char* Ks, const bf16x8* qr, int r32, int hi) {
    p0 = f32x16{}; p1 = f32x16{};
#pragma unroll
    for (int d0 = 0; d0 < 8; ++d0) { const int cb = (d0 * 16 + hi * 8) * 2;
        const bf16x8 b0 = *(const LAS bf16x8*)(Ks + KSWZ(r32, cb));
        const bf16x8 b1 = *(const LAS bf16x8*)(Ks + KSWZ(32 + r32, cb));
        p0 = __builtin_amdgcn_mfma_f32_32x32x16_bf16(b0, qr[d0], p0, 0, 0, 0);
        p1 = __builtin_amdgcn_mfma_f32_32x32x16_bf16(b1, qr[d0], p1, 0, 0, 0); }
}
__device__ __forceinline__ int v_st(int k, int c) { const int kk = (k & ~0xC) | ((k & 4) << 1) | ((k & 8) >> 1); return ((kk >> 3) * 4 + (c >> 5)) * 512 + ((kk & 7) * 32 + (c & 31)) * 2; }
__device__ __forceinline__ int v_rd_base(int lane) { return ((lane & 3) << 3) | (((lane >> 2) & 3) << 6) | (((lane >> 4) & 1) << 5) | (((lane >> 5) & 1) << 8); }
constexpr int v_rd_off(int d0, int ks, int half) { return d0 * 512 + ks * 4096 + half * 2048; }
template <int OFF> __device__ __forceinline__ s16x4 tr_read(int vb) {
    s16x4 r; asm volatile("ds_read_b64_tr_b16 %0, %1 offset:%2" : "=&v"(r) : "v"(vb), "i"(OFF) : "memory"); return r;
}
template <int D0> __device__ __forceinline__ void pv_one(f32x16& od, int vb, bf16x8 pa0, bf16x8 pa1, bf16x8 pa2, bf16x8 pa3) {
    const s16x4 l0 = tr_read<v_rd_off(D0, 0, 0)>(vb), h0 = tr_read<v_rd_off(D0, 0, 1)>(vb), l1 = tr_read<v_rd_off(D0, 1, 0)>(vb), h1 = tr_read<v_rd_off(D0, 1, 1)>(vb);
    const s16x4 l2 = tr_read<v_rd_off(D0, 2, 0)>(vb), h2 = tr_read<v_rd_off(D0, 2, 1)>(vb), l3 = tr_read<v_rd_off(D0, 3, 0)>(vb), h3 = tr_read<v_rd_off(D0, 3, 1)>(vb);
    asm volatile("s_waitcnt lgkmcnt(0)" ::: "memory"); SBAR();
#define PK(L, H) (bf16x8){L[0], L[1], L[2], L[3], H[0], H[1], H[2], H[3]}
    od = __builtin_amdgcn_mfma_f32_32x32x16_bf16(pa0, PK(l0, h0), od, 0, 0, 0);
    od = __builtin_amdgcn_mfma_f32_32x32x16_bf16(pa1, PK(l1, h1), od, 0, 0, 0);
    od = __builtin_amdgcn_mfma_f32_32x32x16_bf16(pa2, PK(l2, h2), od, 0, 0, 0);
    od = __builtin_amdgcn_mfma_f32_32x32x16_bf16(pa3, PK(l3, h3), od, 0, 0, 0);
#undef PK
}
__device__ __forceinline__ void pv_d0(f32x16* o, int vb, bf16x8 pa0, bf16x8 pa1, bf16x8 pa2, bf16x8 pa3) {
    pv_one<0>(o[0], vb, pa0, pa1, pa2, pa3); pv_one<1>(o[1], vb, pa0, pa1, pa2, pa3); pv_one<2>(o[2], vb, pa0, pa1, pa2, pa3); pv_one<3>(o[3], vb, pa0, pa1, pa2, pa3);
}

}

__device__ __forceinline__ void p3b_attention(Frame& F) {
    using namespace att;
    LAS char* lds = (LAS char*)F.lds;
    LAS int* pre = (LAS int*)(lds + PRE_OFF);
    LAS int* wtot = (LAS int*)(lds + WS_OFF);
    LAS float* lutw = (LAS float*)(lds + LUT_OFF);
    const unsigned* acnt = F.ctl + CW_ACNT;
    {
        const int cnt = (int)acnt[F.tid]; int v = 1 + (cnt + 255) / 256;
#pragma unroll
        for (int o = 1; o < 64; o <<= 1) { const int t = __shfl_up(v, o); if (F.lane >= o) v += t; }
        if (F.lane == 63) wtot[F.wave] = v;
        __syncthreads();
        int offs = 0; for (int w = 0; w < F.wave; ++w) offs += wtot[w];
        pre[F.tid + 1] = offs + v; if (F.tid == 0) pre[0] = 0;
        __syncthreads();
    }
    const int T = pre[512];
    const int lo = (int)(((long)F.vcu * T) / F.G), hiT = (int)(((long)(F.vcu + 1) * T) / F.G);
    if (lo >= hiT) return;
    const bf16* Qg = (const bf16*)(F.ws + WS_Q); const bf16* Kg = (const bf16*)(F.ws + WS_K); const bf16* Vg = (const bf16*)(F.ws + WS_V);
    bf16* OP = (bf16*)(F.ws + WS_OPART); f32x2* ML = (f32x2*)(F.ws + WS_ML); const unsigned* lists = (const unsigned*)(F.ws + WS_LISTS);
    constexpr int LDK = DATT;
    const int wid = F.wave;
    LAS char* V_lds = lds; LAS char* K_lds = lds + 2 * SHM_V;
    LAS float* wsf = (LAS float*)(lds + WS_OFF) + wid * 64; LAS float* li_l = wsf; LAS float* al_l = wsf + 32;
    const LAS float* lut = (const LAS float*)(lds + LUT_OFF);
    LAS char* ost = lds + OST_OFF + wid * OST_WAVE;
#define TILE_DESC(g, L_, ti_) do { int a_ = 0, bnd_ = 512; while (bnd_ - a_ > 1) { const int mid_ = (a_ + bnd_) >> 1; if (pre[mid_] <= (g)) a_ = mid_; else bnd_ = mid_; } L_ = a_; ti_ = (g) - pre[a_]; } while (0)
    struct { bf16x8 vs0, vs1, ks0, ks1; } sr_[2];
    bf16x8 qr[8];
    int curh = -1;
    int Lc, tic; TILE_DESC(lo, Lc, tic);
    unsigned entry_c;
    {
        const int lane0 = lane_id(), r32 = lane0 & 31, hi = lane0 >> 5, tid0 = wid * 64 + lane0;
        const int b = Lc >> 8, h = (Lc >> 5) & 7, j = Lc & 31, n = 256 + (int)acnt[Lc];
        const int pos = tic * 256 + wid * 32 + r32;
        entry_c = lists[list_base(b, h, j) + (pos < n ? pos : n - 1)];
        const bf16* Qw = Qg + (size_t)(b * SEQ + (int)(entry_c >> 2)) * DATT + h * HD + hi * 8;
#pragma unroll
        for (int d0 = 0; d0 < 8; ++d0) qr[d0] = *(const bf16x8*)(Qw + d0 * 16);
        const bf16* Kh = Kg + (size_t)(b * SEQ + 256 * j) * DATT + h * HD; const bf16* Vh = Vg + (size_t)(b * SEQ + 256 * j) * DATT + h * HD;
        const int sr = tid0 >> 4, sc = (tid0 & 15) * 8;
        sr_[0].vs0 = *(const bf16x8*)(&Vh[(size_t)sr * LDK + sc]); sr_[0].vs1 = *(const bf16x8*)(&Vh[(size_t)(32 + sr) * LDK + sc]);
        sr_[0].ks0 = *(const bf16x8*)(&Kh[(size_t)sr * LDK + sc]); sr_[0].ks1 = *(const bf16x8*)(&Kh[(size_t)(32 + sr) * LDK + sc]);
    }
    for (int g = lo; g < hiT; ++g) {
        int lane_ = lane_id(); asm volatile("" : "+v"(lane_));
        const int lane = lane_, tid = wid * 64 + lane, r32 = lane & 31, hi = lane >> 5;
        const int b = Lc >> 8, h = (Lc >> 5) & 7, j = Lc & 31, n = 256 + (int)acnt[Lc], ti = tic;
        const bool has_next = g + 1 < hiT;
        int Ln = Lc, tin = tic; if (has_next) TILE_DESC(g + 1, Ln, tin);
        const int bn = Ln >> 8, hn = (Ln >> 5) & 7, jn = Ln & 31;
        unsigned entry_n = 0u;
        if (has_next) { const int nn = 256 + (int)acnt[Ln], posn = tin * 256 + wid * 32 + r32; entry_n = lists[list_base(bn, hn, jn) + (posn < nn ? posn : nn - 1)]; }
        if (h != curh) { __syncthreads(); curh = h;
            for (int idx = F.tid; idx < 513; idx += NTHR) { float v;
                if (idx == 0) v = -INFINITY;
                else { const int rel = idx - 1; int bk = rel;
                    if (rel >= 16) { bk = 16 + (int)(logf((float)rel * (1.0f / 16.0f)) / 2.0794415416798357f * 16.0f); bk = bk > 31 ? 31 : bk; }
                    v = F.rel_bias[bk * 8 + h] * LOG2E; }
                lutw[idx] = v; }
        }
        const int pos = ti * 256 + wid * 32 + r32; const bool valid = pos < n;
        const int qpos = (int)(entry_c >> 2), pick = (int)(entry_c & 3u);
        const int relq = qpos - 256 * j;
        float m_reg = -1e30f, l_reg = 0; f32x16 o[4] = {};
        const bf16* Kh = Kg + (size_t)(b * SEQ + 256 * j) * DATT + h * HD; const bf16* Vh = Vg + (size_t)(b * SEQ + 256 * j) * DATT + h * HD;
        const int sr = tid >> 4, sc = (tid & 15) * 8, vst0 = v_st(sr, sc), vst1 = v_st(32 + sr, sc);
        const int vb0 = (int)(uintptr_t)V_lds + v_rd_base(lane);
#define SLOADP(i, KP, VP, k0) do { sr_[i].vs0 = *(const bf16x8*)(&(VP)[(size_t)((k0) + sr) * LDK + sc]); sr_[i].vs1 = *(const bf16x8*)(&(VP)[(size_t)((k0) + 32 + sr) * LDK + sc]); \
    sr_[i].ks0 = *(const bf16x8*)(&(KP)[(size_t)((k0) + sr) * LDK + sc]); sr_[i].ks1 = *(const bf16x8*)(&(KP)[(size_t)((k0) + 32 + sr) * LDK + sc]); } while (0)
#define SLOAD(i, k0) SLOADP(i, Kh, Vh, k0)
#define SWRITE(bb, i) do { *(LAS bf16x8*)(V_lds + (bb) * SHM_V + vst0) = sr_[i].vs0; *(LAS bf16x8*)(V_lds + (bb) * SHM_V + vst1) = sr_[i].vs1; const int kc = sc * 2; \
    *(LAS bf16x8*)(K_lds + (bb) * SHM_K + KSWZ(sr, kc)) = sr_[i].ks0; *(LAS bf16x8*)(K_lds + (bb) * SHM_K + KSWZ(32 + sr, kc)) = sr_[i].ks1; } while (0)
#define RESC(a) do { if (__any((a) < 1.f)) { if (hi == 0) al_l[r32] = (a); asm volatile("s_waitcnt lgkmcnt(0)" ::: "memory"); \
    _Pragma("unroll") for (int d = 0; d < 4; ++d) _Pragma("unroll") for (int r = 0; r < 16; ++r) o[d][r] *= al_l[crow(r, hi)]; } } while (0)
        f32x16 pA0, pA1, pB0, pB1; float mnA, mnB, alA, alB; bf16x8 pa0, pa1, pa2, pa3;
        __syncthreads();
        SWRITE(0, 0); __syncthreads();
        qkt(pA0, pA1, K_lds, qr, r32, hi); partialSM(pA0, pA1, m_reg, mnA, alA, relq, hi, lut);
        SLOAD(1, KVBLK); SLOAD(0, 2 * KVBLK);
        asm volatile("s_waitcnt vmcnt(4)" ::: "memory"); SWRITE(1, 1); __syncthreads();
        {
            SBAR(); qkt(pB0, pB1, K_lds + SHM_K, qr, r32, hi);
            finishSM(pA0, pA1, alA, l_reg, pa0, pa1, pa2, pa3); SBAR();
            SLOAD(1, 3 * KVBLK); SBAR();
            pv_d0(o, vb0, pa0, pa1, pa2, pa3); partialSM(pB0, pB1, m_reg, mnB, alB, relq - 64, hi, lut);
            __syncthreads(); asm volatile("s_waitcnt vmcnt(4)" ::: "memory"); SWRITE(0, 0);
            if (has_next) { const bf16* Kn = Kg + (size_t)(bn * SEQ + 256 * jn) * DATT + hn * HD; const bf16* Vn = Vg + (size_t)(bn * SEQ + 256 * jn) * DATT + hn * HD; SLOADP(0, Kn, Vn, 0); }
            RESC(alB); __syncthreads();
            SBAR(); qkt(pA0, pA1, K_lds, qr, r32, hi);
            finishSM(pB0, pB1, alB, l_reg, pa0, pa1, pa2, pa3); SBAR();
            pv_d0(o, vb0 + SHM_V, pa0, pa1, pa2, pa3); partialSM(pA0, pA1, m_reg, mnA, alA, relq - 128, hi, lut);
            __syncthreads(); SWRITE(1, 1);
            RESC(alA); __syncthreads();
        }
        SBAR(); qkt(pB0, pB1, K_lds + SHM_K, qr, r32, hi);
        if (has_next) { const bf16* Qw = Qg + (size_t)(bn * SEQ + (int)(entry_n >> 2)) * DATT + hn * HD + hi * 8;
#pragma unroll
            for (int d0 = 0; d0 < 8; ++d0) qr[d0] = *(const bf16x8*)(Qw + d0 * 16); }
        finishSM(pA0, pA1, alA, l_reg, pa0, pa1, pa2, pa3); SBAR();
        pv_d0(o, vb0, pa0, pa1, pa2, pa3); partialSM(pB0, pB1, m_reg, mnB, alB, relq - 192, hi, lut);
        __syncthreads(); RESC(alB);
        finishSM(pB0, pB1, alB, l_reg, pa0, pa1, pa2, pa3); SBAR();
        pv_d0(o, vb0 + SHM_V, pa0, pa1, pa2, pa3);
        if (hi == 0) li_l[r32] = l_reg; asm volatile("s_waitcnt lgkmcnt(0)" ::: "memory");
#pragma unroll
        for (int r = 0; r < 16; ++r) { const int orow = crow(r, hi); const float rl = __builtin_amdgcn_rcpf(li_l[orow]);
#pragma unroll
            for (int d0 = 0; d0 < 4; ++d0) *(LAS bf16*)(ost + orow * OST_STRIDE + (d0 * 32 + r32) * 2) = (bf16)(cvt_pk_bf16(o[d0][r] * rl, 0.f) & 0xffffu); }
        asm volatile("s_waitcnt lgkmcnt(0)" ::: "memory");
        const size_t rowbase = (((size_t)(b * 8 + h) * SEQ + qpos) * 4 + pick);
        if (hi == 0 && valid) ML[rowbase] = (f32x2){m_reg, l_reg};
        { int lq = lane >> 4, lc = lane & 15; asm volatile("" : "+v"(lq), "+v"(lc));
          const LAS char* rbp = ost + lq * OST_STRIDE + lc * 16;
          const unsigned rbu = (unsigned)rowbase;
#pragma unroll
          for (int it = 0; it < 8; ++it) { const int row = it * 4 + lq;
            const unsigned rb = (unsigned)__shfl((int)rbu, row); const int vld = __shfl((int)valid, row);
            const u32x4 w = *(const LAS u32x4*)(rbp + it * 4 * OST_STRIDE);
            if (vld) *(u32x4*)(OP + (size_t)rb * HD + lc * 8) = w; } }
#undef SLOADP
#undef SLOAD
#undef SWRITE
#undef RESC
        Lc = Ln; tic = tin; entry_c = entry_n;
    }
#undef TILE_DESC
    __syncthreads();
}

__device__ __forceinline__ void p3c_combine(Frame& F) {
    const int gw = F.vcu * NWAVES + F.wave, NGW = F.G * NWAVES;
    const bf16* OP = (const bf16*)(F.ws + WS_OPART); const f32x2* ML = (const f32x2*)(F.ws + WS_ML); bf16* YATT = (bf16*)(F.ws + WS_YATT);
    const int h = F.lane >> 3, dch = F.lane & 7;
    for (int m = gw; m < MTOK; m += NGW) { const int b = m / SEQ, s = m % SEQ;
        const size_t rb = ((size_t)(b * 8 + h) * SEQ + s) * 4;
        f32x2 ml[4]; float M = -1e30f;
#pragma unroll
        for (int p = 0; p < 4; ++p) { ml[p] = ML[rb + p]; if (ml[p].y > 0.f) M = fmaxf(M, ml[p].x); }
        float acc[16]; float wsum = 0.f;
#pragma unroll
        for (int e = 0; e < 16; ++e) acc[e] = 0.f;
#pragma unroll
        for (int p = 0; p < 4; ++p) if (ml[p].y > 0.f) { const float w = ml[p].y * __builtin_amdgcn_exp2f(ml[p].x - M); wsum += w;
            const u32x4* src = (const u32x4*)(OP + (rb + p) * HD + dch * 16); const u32x4 a = src[0], c = src[1];
            const unsigned wv[8] = {a.x, a.y, a.z, a.w, c.x, c.y, c.z, c.w};
#pragma unroll
            for (int e = 0; e < 8; ++e) { acc[2 * e] += w * bf_lo(wv[e]); acc[2 * e + 1] += w * bf_hi(wv[e]); } }
        const float inv = 1.0f / wsum;
        u32x4 o0, o1;
        o0.x = cvt_pk_bf16(acc[0] * inv, acc[1] * inv); o0.y = cvt_pk_bf16(acc[2] * inv, acc[3] * inv); o0.z = cvt_pk_bf16(acc[4] * inv, acc[5] * inv); o0.w = cvt_pk_bf16(acc[6] * inv, acc[7] * inv);
        o1.x = cvt_pk_bf16(acc[8] * inv, acc[9] * inv); o1.y = cvt_pk_bf16(acc[10] * inv, acc[11] * inv); o1.z = cvt_pk_bf16(acc[12] * inv, acc[13] * inv); o1.w = cvt_pk_bf16(acc[14] * inv, acc[15] * inv);
        u32x4* dst = (u32x4*)(YATT + (size_t)m * DATT + h * HD + dch * 16); dst[0] = o0; dst[1] = o1; }
}

__device__ __forceinline__ void p6_route(Frame& F) {
    {
        LAS float* scr = (LAS float*)(F.lds + F.wave * 16384);
        const int gw = F.vcu * NWAVES + F.wave, NGW = F.G * NWAVES;
        bf16* W13T = (bf16*)(F.ws + WS_W13T); bf16* W2T = (bf16*)(F.ws + WS_W2T);
#define P6_ITEM(it, T) do { const int which = (it) >> 13, r = (it) & 8191, e = r >> 9, q = r & 511; \
        if (which < 2) { const int kb = q >> 4, nb = q & 15, n0 = 32 * nb; \
            T = TrItem{(which ? F.w_eu : F.w_eg) + (size_t)e * DM * DE, W13T, DE, DM, 64 * kb, n0, e * 1024 + 256 * (n0 >> 7) + which * 128 + (n0 & 127)}; } \
        else { const int kb = q >> 6, nb = q & 63; T = TrItem{F.w_ed + (size_t)e * DE * DM, W2T, DM, DE, 64 * kb, 32 * nb, e * 2048 + 32 * nb}; } } while (0)
        TRANSPOSE_LOOP(gw, NGW, 3 * 8192, P6_ITEM);
#undef P6_ITEM
    MIDSTAMP(F, 14);
    }
    __syncthreads();
    LAS float* pbuf = (LAS float*)F.lds;
    LAS float* lg = (LAS float*)(F.lds + 16384);
    LAS int* lcnt = (LAS int*)(F.lds + 24576); LAS int* gb = lcnt + 16;
    LAS float* a2s = (LAS float*)(F.lds + 28672); LAS float* sh2s = (LAS float*)(F.lds + 36864);
    LAS float* rcw = (LAS float*)(F.lds + 45056); LAS float* rcs = rcw + 160;
    LAS float* rinfo = (LAS float*)(F.lds + 24832);
    const float* x1 = F.out; const float* SSQ = (const float*)(F.ws + WS_SSQ); const float* A2 = (const float*)(F.ws + WS_A2);
    const float* mod = (const float*)(F.ws + WS_MOD); const bf16* WR = (const bf16*)(F.ws + WS_WR);
    bf16* H2 = (bf16*)(F.ws + WS_H2);
    for (int rb = F.vcu * 64; rb < MTOK; rb += F.G * 64) {
        const int bk = F.wave >> 1, kh = F.wave & 1, r = F.lane & 15, g4 = F.lane >> 4, row = rb + bk * 16 + r, b = row / SEQ;
        if (F.tid < 16) lcnt[F.tid] = 0;
        *(LAS f32x4*)(a2s + 4 * F.tid) = *(const f32x4*)(A2 + b * DM + 4 * F.tid); *(LAS f32x4*)(sh2s + 4 * F.tid) = *(const f32x4*)(mod + b * (6 * DM) + 3 * DM + 4 * F.tid);
        __syncthreads();
        {
            float pc[20];
#pragma unroll
            for (int c = 0; c < 20; ++c) pc[c] = 0.f;
            const f32x4 sh = *(const LAS f32x4*)(sh2s + 4 * F.tid); const float shk[4] = {sh.x, sh.y, sh.z, sh.w};
#pragma unroll
            for (int kk = 0; kk < 4; ++kk) { const int k = 4 * F.tid + kk; const f32x4 g = *(const f32x4*)(F.w_rg + k * 4);
                pc[0] += shk[kk] * g.x; pc[1] += shk[kk] * g.y; pc[2] += shk[kk] * g.z; pc[3] += shk[kk] * g.w;
#pragma unroll
                for (int q = 0; q < 4; ++q) { const f32x4 e = *(const f32x4*)(F.w_re + k * 16 + 4 * q); pc[4 + 4 * q] += shk[kk] * e.x; pc[5 + 4 * q] += shk[kk] * e.y; pc[6 + 4 * q] += shk[kk] * e.z; pc[7 + 4 * q] += shk[kk] * e.w; } }
#pragma unroll
            for (int c = 0; c < 20; ++c) { const float t = wave_sum(pc[c]); if (F.lane == 0) rcw[F.wave * 20 + c] = t; }
            __syncthreads();
            if (F.tid < 20) { float t = 0.f; for (int w = 0; w < 8; ++w) t += rcw[w * 20 + F.tid]; rcs[F.tid] = t; }
            __syncthreads();
        }
        float rstd;
        { const f32x4 s0 = *(const f32x4*)(SSQ + (size_t)row * 32 + g4 * 8), s1 = *(const f32x4*)(SSQ + (size_t)row * 32 + g4 * 8 + 4);
          float s = ((s0.x + s0.y) + (s0.z + s0.w)) + ((s1.x + s1.y) + (s1.z + s1.w)); s += __shfl_xor(s, 16); s += __shfl_xor(s, 32);
          rstd = 1.0f / sqrtf(s * (1.0f / DM) + EPS); }
        f32x4 acc0 = {0.f, 0.f, 0.f, 0.f}, acc1 = {0.f, 0.f, 0.f, 0.f};
        const float* xr = x1 + (size_t)row * DM;
        const bf16* wh0 = WR + ((size_t)(b * 2 + 0) * 32 + r) * DM, * wl0 = WR + ((size_t)(b * 2 + 1) * 32 + r) * DM;
        struct RB { f32x4 xa[2], xb[2]; bf16x8 bh0[2], bl0[2], bh1[2], bl1[2]; } BA, BB;
#define RT_LOAD(X, it) do { _Pragma("unroll") for (int u = 0; u < 2; ++u) { const int kk = kh * 1024 + ((it) + u) * 32 + 8 * g4; \
            X.xa[u] = *(const f32x4*)(xr + kk); X.xb[u] = *(const f32x4*)(xr + kk + 4); \
            X.bh0[u] = *(const bf16x8*)(wh0 + kk); X.bl0[u] = *(const bf16x8*)(wl0 + kk); X.bh1[u] = *(const bf16x8*)(wh0 + 16 * DM + kk); X.bl1[u] = *(const bf16x8*)(wl0 + 16 * DM + kk); } } while (0)
#define RT_COMP(X, it) do { _Pragma("unroll") for (int u = 0; u < 2; ++u) { const int kk = kh * 1024 + ((it) + u) * 32 + 8 * g4; \
            const f32x4 aa = *(const LAS f32x4*)(a2s + kk), ab = *(const LAS f32x4*)(a2s + kk + 4), sa = *(const LAS f32x4*)(sh2s + kk), sb = *(const LAS f32x4*)(sh2s + kk + 4); \
            const f32x4 xa = X.xa[u], xb = X.xb[u]; const f32x4 ha = xa * rstd * aa + sa, hb = xb * rstd * ab + sb; \
            u32x4 hw; hw.x = cvt_pk_bf16(ha.x, ha.y); hw.y = cvt_pk_bf16(ha.z, ha.w); hw.z = cvt_pk_bf16(hb.x, hb.y); hw.w = cvt_pk_bf16(hb.z, hb.w); \
            *(u32x4*)(H2 + (size_t)row * DM + kk) = hw; \
            u32x4 xh; xh.x = cvt_pk_bf16(xa.x, xa.y); xh.y = cvt_pk_bf16(xa.z, xa.w); xh.z = cvt_pk_bf16(xb.x, xb.y); xh.w = cvt_pk_bf16(xb.z, xb.w); \
            u32x4 xl; xl.x = cvt_pk_bf16(xa.x - bf_lo(xh.x), xa.y - bf_hi(xh.x)); xl.y = cvt_pk_bf16(xa.z - bf_lo(xh.y), xa.w - bf_hi(xh.y)); \
            xl.z = cvt_pk_bf16(xb.x - bf_lo(xh.z), xb.y - bf_hi(xh.z)); xl.w = cvt_pk_bf16(xb.z - bf_lo(xh.w), xb.w - bf_hi(xh.w)); \
            const bf16x8 ah = __builtin_bit_cast(bf16x8, xh), al = __builtin_bit_cast(bf16x8, xl); \
            acc0 = __builtin_amdgcn_mfma_f32_16x16x32_bf16(ah, X.bh0[u], acc0, 0, 0, 0); acc0 = __builtin_amdgcn_mfma_f32_16x16x32_bf16(al, X.bh0[u], acc0, 0, 0, 0); acc0 = __builtin_amdgcn_mfma_f32_16x16x32_bf16(ah, X.bl0[u], acc0, 0, 0, 0); \
            acc1 = __builtin_amdgcn_mfma_f32_16x16x32_bf16(ah, X.bh1[u], acc1, 0, 0, 0); acc1 = __builtin_amdgcn_mfma_f32_16x16x32_bf16(al, X.bh1[u], acc1, 0, 0, 0); acc1 = __builtin_amdgcn_mfma_f32_16x16x32_bf16(ah, X.bl1[u], acc1, 0, 0, 0); } } while (0)
        RT_LOAD(BA, 0);
        for (int it0 = 0; it0 < 32; it0 += 4) { RT_LOAD(BB, it0 + 2); RT_COMP(BA, it0); if (it0 + 4 < 32) RT_LOAD(BA, it0 + 4); RT_COMP(BB, it0 + 2); }
#undef RT_LOAD
#undef RT_COMP
#pragma unroll
        for (int e = 0; e < 4; ++e) { pbuf[((bk * 2 + kh) * 16 + 4 * g4 + e) * 32 + r] = acc0[e]; pbuf[((bk * 2 + kh) * 16 + 4 * g4 + e) * 32 + 16 + r] = acc1[e]; }
        __syncthreads();
        if (kh == 0 && F.lane < 16) {
            const int lrow = bk * 16 + F.lane;
            for (int c = 0; c < 20; ++c) lg[lrow * 32 + c] = rstd * (pbuf[((bk * 2 + 0) * 16 + F.lane) * 32 + c] + pbuf[((bk * 2 + 1) * 16 + F.lane) * 32 + c]) + rcs[c];
            int gi = 0; float gm = lg[lrow * 32];
            for (int c = 1; c < 4; ++c) { const float v = lg[lrow * 32 + c]; if (v > gm) { gm = v; gi = c; } }
            float gs = 0.f; for (int c = 0; c < 4; ++c) gs += expf(lg[lrow * 32 + c] - gm);
            const float gp = 1.0f / gs;
            const LAS float* el = lg + lrow * 32 + 4 + 4 * gi;
            int i0 = 0; float m0 = el[0]; for (int c = 1; c < 4; ++c) if (el[c] > m0) { m0 = el[c]; i0 = c; }
            int i1 = -1; float m1 = -INFINITY; for (int c = 0; c < 4; ++c) if (c != i0 && el[c] > m1) { m1 = el[c]; i1 = c; }
            const float t = expf(m1 - m0), w0 = gp / (1.0f + t), w1 = gp * t / (1.0f + t);
            const int e0 = 4 * gi + i0, e1 = 4 * gi + i1;
            const int p0 = atomicAdd((int*)&lcnt[e0], 1), p1 = atomicAdd((int*)&lcnt[e1], 1);
            LAS float* ri = rinfo + lrow * 8; ri[0] = __int_as_float(e0); ri[1] = __int_as_float(p0); ri[2] = w0; ri[3] = __int_as_float(e1); ri[4] = __int_as_float(p1); ri[5] = w1;
        }
        __syncthreads();
        if (F.tid < 16) { const int n = lcnt[F.tid]; gb[F.tid] = n > 0 ? (int)atomicAdd(F.ctl + CW_ECNT + 64 * F.tid, (unsigned)n) : 0; }
        __syncthreads();
        if (F.tid < 64) { const LAS float* ri = rinfo + F.tid * 8; const unsigned tok = (unsigned)(rb + F.tid);
            unsigned* ST = (unsigned*)(F.ws + WS_SLOTTOK); float* SW = (float*)(F.ws + WS_SLOTW);
            const int e0 = __float_as_int(ri[0]), e1 = __float_as_int(ri[3]);
            const int s0 = e0 * 16384 + gb[e0] + __float_as_int(ri[1]), s1 = e1 * 16384 + gb[e1] + __float_as_int(ri[4]);
            ST[s0] = tok; SW[s0] = ri[2]; ST[s1] = tok | 0x10000u; SW[s1] = ri[5]; }
        __syncthreads();
    }
}

__device__ __forceinline__ void moe_table(Frame& F, LAS int* tab) {
    __syncthreads();
    if (F.tid == 0) { int acc = 0; for (int e = 0; e < 16; ++e) { const int n = (int)F.ctl[CW_ECNT + 64 * e]; tab[e] = acc; tab[32 + e] = n; acc += (n + 255) >> 8; } tab[16] = acc; }
    __syncthreads();
}

__device__ __forceinline__ void p9_final(Frame& F) {
    const int gw = F.vcu * NWAVES + F.wave, NGW = F.G * NWAVES;
    const float* mod = (const float*)(F.ws + WS_MOD); const bf16* O0 = (const bf16*)(F.ws + WS_O0); const bf16* O1 = (const bf16*)(F.ws + WS_O1);
    int curb = -1; f32x4 gv[8], fw[8];
#pragma unroll
    for (int j = 0; j < 8; ++j) fw[j] = *(const f32x4*)(F.final_w + 4 * F.lane + 256 * j);
    for (int m = gw; m < MTOK; m += 2 * NGW) {
        const int b = m / SEQ;
        if (b != curb) { curb = b;
#pragma unroll
            for (int j = 0; j < 8; ++j) gv[j] = *(const f32x4*)(mod + b * (6 * DM) + 5 * DM + 4 * F.lane + 256 * j); }
        f32x4* xr0 = (f32x4*)(F.out + (size_t)m * DM) + F.lane; f32x4* xr1 = (f32x4*)(F.out + (size_t)(m + NGW) * DM) + F.lane;
        const u32x2* p00 = (const u32x2*)(O0 + (size_t)m * DM) + F.lane; const u32x2* p01 = (const u32x2*)(O1 + (size_t)m * DM) + F.lane;
        const u32x2* p10 = (const u32x2*)(O0 + (size_t)(m + NGW) * DM) + F.lane; const u32x2* p11 = (const u32x2*)(O1 + (size_t)(m + NGW) * DM) + F.lane;
        f32x4 v0[8], v1[8]; u32x2 a0[8], c0[8], a1[8], c1[8]; float s0 = 0.f, s1 = 0.f;
#pragma unroll
        for (int j = 0; j < 8; ++j) { v0[j] = xr0[64 * j]; a0[j] = p00[64 * j]; c0[j] = p01[64 * j]; v1[j] = xr1[64 * j]; a1[j] = p10[64 * j]; c1[j] = p11[64 * j]; }
#pragma unroll
        for (int j = 0; j < 8; ++j) {
            const f32x4 y0 = {bf_lo(a0[j].x) + bf_lo(c0[j].x), bf_hi(a0[j].x) + bf_hi(c0[j].x), bf_lo(a0[j].y) + bf_lo(c0[j].y), bf_hi(a0[j].y) + bf_hi(c0[j].y)};
            const f32x4 y1 = {bf_lo(a1[j].x) + bf_lo(c1[j].x), bf_hi(a1[j].x) + bf_hi(c1[j].x), bf_lo(a1[j].y) + bf_lo(c1[j].y), bf_hi(a1[j].y) + bf_hi(c1[j].y)};
            v0[j] = v0[j] + gv[j] * y0; v1[j] = v1[j] + gv[j] * y1;
            s0 += (v0[j].x * v0[j].x + v0[j].y * v0[j].y) + (v0[j].z * v0[j].z + v0[j].w * v0[j].w); s1 += (v1[j].x * v1[j].x + v1[j].y * v1[j].y) + (v1[j].z * v1[j].z + v1[j].w * v1[j].w); }
        const float r0 = 1.0f / sqrtf(wave_sum(s0) * (1.0f / DM) + EPS), r1 = 1.0f / sqrtf(wave_sum(s1) * (1.0f / DM) + EPS);
#pragma unroll
        for (int j = 0; j < 8; ++j) { xr0[64 * j] = v0[j] * r0 * fw[j]; xr1[64 * j] = v1[j] * r1 * fw[j]; }
    }
}

constexpr int N_PHASES = 12;
struct Args { const float* in[21]; float* out; unsigned char* ws; int ph_lo, ph_hi; };
__global__ void __launch_bounds__(NTHR, 2) fwd_kernel(Args args) {
    extern __shared__ __attribute__((aligned(16))) unsigned char lds_raw[];
    Frame F;
    F.lds = (LAS unsigned char*)lds_raw; F.MISC = (volatile LAS unsigned*)(F.lds + MISC_OFF);
    F.wave = __builtin_amdgcn_readfirstlane(threadIdx.x >> 6); F.lane = lane_id(); F.tid = F.wave * 64 + F.lane;
    F.G = gridDim.x; { const int bx = blockIdx.x; F.vcu = (F.G % 8 == 0) ? (bx % 8) * (F.G / 8) + bx / 8 : bx; }
    F.ws = args.ws; F.ctl = (unsigned*)(args.ws + WS_CTL); F.out = args.out;
    F.x = args.in[0]; F.c = args.in[1]; F.w_ada = args.in[2]; F.b_ada = args.in[3]; F.norm1_w = args.in[4]; F.norm2_w = args.in[5]; F.final_w = args.in[6]; F.w_in = args.in[7];
    F.sg_ln_w = args.in[8]; F.sg_ln_b = args.in[9]; F.w_spatial = args.in[10]; F.b_spatial = args.in[11]; F.rel_bias = args.in[12]; F.w_out_sg = args.in[13]; F.w_out_att = args.in[14];
    F.w_o = args.in[15]; F.w_rg = args.in[16]; F.w_re = args.in[17]; F.w_eg = args.in[18]; F.w_eu = args.in[19]; F.w_ed = args.in[20];
    for (int u = F.tid; u < (LDS_BYTES - MISC_OFF) / 4; u += NTHR) ((LAS unsigned*)(F.lds + MISC_OFF))[u] = 0u;
    __syncthreads();
    const int lo = args.ph_lo, hi = args.ph_hi;
    XcdBarrier bar; bar.bar = F.ctl + CW_BAR; bar.x = 0; bar.st = nullptr; bar.wid = F.wave;
    if (hi - lo > 1) bar = xcd_barrier_post(F.ctl + CW_BAR, F.MISC + 8, F.wave);
#ifndef PHASE_MASK
#define PHASE_MASK 0xFFF
#endif
#define IN(k) (((PHASE_MASK >> (k)) & 1) && lo <= (k) && (k) < hi && ((F.lane = lane_id()), (F.tid = F.wave * 64 + F.lane), true))
#define SEAM(k) do { if (IN(k) && IN((k) + 1)) xcd_barrier(bar); } while (0)
#ifndef REPEAT_MASK
#define REPEAT_MASK 0
#endif
    LAS int* tab = (LAS int*)(F.lds + TAB_OFF);

#define BODY_0 { p0_prologue(F); }
#define BODY_1 { p1_norm1(F); }
#define BODY_2 { SchedGrid S{(const char*)(F.ws + WS_H), (const char*)(F.ws + WS_WINT), 36, 64 * 36, F.G, F.vcu, (size_t)256 * DM * 2, (size_t)256 * DM * 2}; \
        EpiProj E{F.ws, (float*)(F.ctl + CW_KSUM)}; \
        pg8::gemm_phase<DM, true, false>(F.lds, F.wave, S, E); }
#define BODY_3 { for (int u = F.vcu; u < 256; u += F.G) sgu_unit(F, u >> 7, (u >> 1) & 63, u & 1); \
        for (int u = F.vcu; u < 512; u += F.G) { const int i5 = u & 31; select_unit(F, u >> 8, (u >> 5) & 7, (u & 256) ? 31 - i5 : i5); } }
#define BODY_4 { p3b_attention(F); }
#define BODY_5 { p3c_combine(F); }
#define BODY_6 { SchedPair S{(const char*)(F.ws + WS_YSG), (const char*)(F.ws + WS_YATT), (const char*)(F.ws + WS_WOSGT), (const char*)(F.ws + WS_WOATTT), F.G, F.vcu}; \
        EpiMerge E{(const bf16*)(F.ws + WS_GS), (const bf16*)(F.ws + WS_GA), (bf16*)(F.ws + WS_MERGED)}; \
        pg8::gemm_phase<1024, true, false>(F.lds, F.wave, S, E); }
#define BODY_7 { SchedGrid S{(const char*)(F.ws + WS_MERGED), (const char*)(F.ws + WS_WOT), 8, 64 * 8, F.G, F.vcu, (size_t)256 * DM * 2, (size_t)256 * DM * 2}; \
        EpiX1 E{F.x, (const float*)(F.ws + WS_MOD), F.out, (float*)(F.ws + WS_SSQ)}; \
        pg8::gemm_phase<DM, false, false>(F.lds, F.wave, S, E); }
#define BODY_8 { p6_route(F); }
#define BODY_9 { moe_table(F, tab); \
        SchedMoe S{(const unsigned*)(F.ws + WS_SLOTTOK), (const char*)(F.ws + WS_H2), (const char*)(F.ws + WS_W13T), tab, F.G, F.vcu, 2, (size_t)1024 * DM * 2, (size_t)256 * DM * 2, 0}; \
        EpiSwiglu E{(bf16*)(F.ws + WS_ACT)}; \
        pg8::gemm_phase<DM, true, true>(F.lds, F.wave, S, E); }
#define BODY_10 { moe_table(F, tab); \
        SchedMoe S{(const unsigned*)(F.ws + WS_SLOTTOK), (const char*)(F.ws + WS_ACT), (const char*)(F.ws + WS_W2T), tab, F.G, F.vcu, 3, (size_t)DM * DE * 2, (size_t)256 * DE * 2, (size_t)256 * DE * 2}; \
        EpiDown E{(const unsigned*)(F.ws + WS_SLOTTOK), (const float*)(F.ws + WS_SLOTW), tab, (bf16*)(F.ws + WS_O0), (bf16*)(F.ws + WS_O1)}; \
        pg8::gemm_phase<DE, true, false>(F.lds, F.wave, S, E); }
#define BODY_11 { p9_final(F); }
#ifndef PROBE_FROM
#define PROBE_FROM 0
#define PROBE_TO 0
#endif
#define PROBE_MASK (PROBE_TO != PROBE_FROM)
#define STAMP(k) do { if (PROBE_MASK && blockIdx.x == 0 && F.tid == 0) { const unsigned long long t_ = __builtin_amdgcn_s_memrealtime(); F.MISC[32 + 2 * (k)] = (unsigned)t_; F.MISC[33 + 2 * (k)] = (unsigned)(t_ >> 32); } } while (0)
#define RUN(k) do { if (IN(k)) { BODY_##k; if ((REPEAT_MASK >> (k)) & 1) { xcd_barrier(bar); BODY_##k; } } SEAM(k); STAMP((k) + 1); } while (0)
    STAMP(0);
    RUN(0); RUN(1); RUN(2); RUN(3); RUN(4); RUN(5); RUN(6); RUN(7); RUN(8); RUN(9); RUN(10);
    if (IN(11)) { BODY_11; }
    STAMP(12);
    if (PROBE_MASK && blockIdx.x == 0 && F.tid == 0) {
        const unsigned long long a = ((unsigned long long)F.MISC[33 + 2 * PROBE_FROM] << 32) | F.MISC[32 + 2 * PROBE_FROM], b = ((unsigned long long)F.MISC[33 + 2 * PROBE_TO] << 32) | F.MISC[32 + 2 * PROBE_TO];
        const unsigned long long tot = b - a, t0 = __builtin_amdgcn_s_memrealtime();
        while (__builtin_amdgcn_s_memrealtime() - t0 < 8ull * tot) __builtin_amdgcn_s_sleep(8);
    }
#undef IN
#undef SEAM
}

extern "C" void kernel_launch(void* const* d_in, const int* in_sizes, int n_in, void* d_out, int out_size, void* d_ws, size_t ws_size, hipStream_t stream) {
    static int grid = 0;
    if (grid == 0) {
        if (n_in != 21 || in_sizes[0] != MTOK * DM || out_size != MTOK * DM || ws_size < WS_END) {
            fprintf(stderr, "kernel_launch: unexpected shapes (n_in %d, in0 %d, out %d, ws %zu, need ws >= %zu); nothing launched\n", n_in, n_in > 0 ? in_sizes[0] : -1, out_size, ws_size, (size_t)WS_END); grid = -1; return; }
        int dev = 0, cus = 0, per_cu = 0;
        if (hipGetDevice(&dev) != hipSuccess || hipDeviceGetAttribute(&cus, hipDeviceAttributeMultiprocessorCount, dev) != hipSuccess) { grid = -1; return; }
        if (hipFuncSetAttribute((const void*)fwd_kernel, hipFuncAttributeMaxDynamicSharedMemorySize, LDS_BYTES) != hipSuccess) { fprintf(stderr, "kernel_launch: hipFuncSetAttribute failed\n"); grid = -1; return; }
        if (hipOccupancyMaxActiveBlocksPerMultiprocessor(&per_cu, (const void*)fwd_kernel, NTHR, LDS_BYTES) != hipSuccess || per_cu < 1) { fprintf(stderr, "kernel_launch: occupancy query says %d\n", per_cu); }
        (void)hipGetLastError();
        grid = cus;
    }
    if (grid < 0) return;
    if (hipMemsetAsync((char*)d_ws + WS_CTL, 0, CTL_ZERO_BYTES, stream) != hipSuccess) return;
    Args a{};
    for (int i = 0; i < 21; ++i) a.in[i] = (const float*)d_in[i];
    a.out = (float*)d_out; a.ws = (unsigned char*)d_ws;
#if MK_N_LAUNCHES == 1
    a.ph_lo = 0; a.ph_hi = N_PHASES;
    hipLaunchKernelGGL(fwd_kernel, dim3(grid), dim3(NTHR), LDS_BYTES, stream, a);
#else
    for (int p = 0; p < N_PHASES; ++p) { a.ph_lo = p; a.ph_hi = p + 1; hipLaunchKernelGGL(fwd_kernel, dim3(grid), dim3(NTHR), LDS_BYTES, stream, a); }
#endif
    const hipError_t le = hipPeekAtLastError();
    if (le != hipSuccess) fprintf(stderr, "kernel_launch: launch failed: %s\n", hipGetErrorName(le));
}
```
